# Optimizing an MI355X kernel written in HIP

```python
import math
import jax, jax.numpy as jnp
from jax import lax
import numpy as np

D_MODEL = 1024
BATCH = 32
SEQ = 2048
DEPTH = 1
DEC_BATCH = 32
DEC_SEQ = 32
PAST_LEN = 2048

CHUNK = 64
Q_BLOCK = 128
H_A = 8
D_NOPE = 64
D_ROPE = 32
D_VA = 64
D_CQ = 256
D_CKV = 256
ROPE_BASE = 10000.0
H_B = 4
D_HB = 64
W_B = H_B * 2 * D_HB
D_MIX = H_A * D_VA + W_B
D_IN = D_CQ + D_CKV + D_ROPE + 3 * W_B
D_FF = 2816
CONV_W = 3
D_PLE = 256
ALPHA = (2 * DEPTH) ** 0.25
BETA = (8 * DEPTH) ** -0.25
EPS = 1e-5

kernel_name = "hymba_mla_diffattn_convglu_stream_step"


def _rms(x, g):
    xf = x.astype(jnp.float32)
    y = xf * lax.rsqrt(jnp.mean(xf * xf, -1, keepdims=True) + EPS)
    return (y * g.astype(jnp.float32)).astype(x.dtype)


def _ln(x, g, b):
    xf = x.astype(jnp.float32)
    mu = jnp.mean(xf, -1, keepdims=True)
    var = jnp.mean(jnp.square(xf - mu), -1, keepdims=True)
    y = (xf - mu) * lax.rsqrt(var + EPS)
    return (y * g.astype(jnp.float32) + b.astype(jnp.float32)).astype(x.dtype)


def _rope(x, pos):
    half = D_ROPE // 2
    inv = 1.0 / (ROPE_BASE ** (jnp.arange(half, dtype=jnp.float32) / half))
    ang = pos.astype(jnp.float32)[:, None] * inv[None, :]
    shape = (1, pos.shape[0]) + (1,) * (x.ndim - 3) + (half,)
    cos = jnp.cos(ang).reshape(shape)
    sin = jnp.sin(ang).reshape(shape)
    xf = x.astype(jnp.float32)
    x1, x2 = xf[..., :half], xf[..., half:]
    return jnp.concatenate([x1 * cos - x2 * sin, x1 * sin + x2 * cos], -1).astype(x.dtype)


def _alibi_slopes(n):
    return np.array([2.0 ** (-8.0 * (h + 1) / n) for h in range(n)], dtype=np.float32)


def _attend(q, k, v, q_pos, k_pos, slopes, coef, scale):
    b, sq, h, m, dk = q.shape
    bs = Q_BLOCK if sq % Q_BLOCK == 0 else sq
    nb = sq // bs
    k_chunk = k_pos // CHUNK
    coef32 = coef.astype(jnp.float32)

    def block(args):
        qb, pb = args
        s = jnp.einsum('bqhmd,bkhmd->bhmqk', qb, k).astype(jnp.float32) * scale
        if slopes is not None:
            dist = jnp.abs(pb[:, None] - k_pos[None, :]).astype(jnp.float32)
            s = s - slopes[None, :, None, None, None] * dist
        allowed = k_chunk[None, :] <= (pb // CHUNK)[:, None]
        s = jnp.where(allowed, s, -jnp.inf)
        p = jax.nn.softmax(s, axis=-1)
        w = jnp.einsum('bhmqk,hm->bhqk', p, coef32).astype(v.dtype)
        return jnp.einsum('bhqk,bkhd->bqhd', w, v)

    qs = jnp.moveaxis(q.reshape(b, nb, bs, h, m, dk), 1, 0)
    ps = q_pos.reshape(nb, bs)
    o = lax.map(block, (qs, ps))
    return jnp.moveaxis(o, 0, 1).reshape(b, sq, h, v.shape[-1])


def _token_mixers(x, pos, past, lp, layer_idx):
    b, s, _ = x.shape
    proj = x @ lp['w_in']
    o1 = D_CQ
    o2 = o1 + D_CKV
    o3 = o2 + D_ROPE
    o4 = o3 + W_B
    o5 = o4 + W_B
    c_q = _rms(proj[..., :o1], lp['g_cq'])
    c_kv = _rms(proj[..., o1:o2], lp['g_ckv'])
    k_r = _rope(proj[..., o2:o3], pos)
    dq = proj[..., o3:o4].reshape(b, s, H_B, 2, D_HB)
    dk = proj[..., o4:o5].reshape(b, s, H_B, 2, D_HB)
    dv = proj[..., o5:].reshape(b, s, H_B, 2 * D_HB)
    q = (c_q @ lp['w_uq']).reshape(b, s, H_A, D_NOPE + D_ROPE)
    q = jnp.concatenate([q[..., :D_NOPE], _rope(q[..., D_NOPE:], pos)], -1)
    if past is None:
        k_pos = pos
        c_all, kr_all, dk_all, dv_all = c_kv, k_r, dk, dv
    else:
        p_ckv, p_kr, p_dk, p_dv = past
        k_pos = jnp.arange(p_ckv.shape[1] + s)
        c_all = jnp.concatenate([p_ckv, c_kv], 1)
        kr_all = jnp.concatenate([p_kr, k_r], 1)
        dk_all = jnp.concatenate([p_dk, dk], 1)
        dv_all = jnp.concatenate([p_dv, dv], 1)
    sk = c_all.shape[1]
    k_nope = (c_all @ lp['w_uk']).reshape(b, sk, H_A, D_NOPE)
    v_a = (c_all @ lp['w_uv']).reshape(b, sk, H_A, D_VA)
    k_a = jnp.concatenate([k_nope, jnp.broadcast_to(kr_all[:, :, None, :], (b, sk, H_A, D_ROPE))], -1)
    o_a = _attend(q[:, :, :, None, :], k_a[:, :, :, None, :], v_a, pos, k_pos, None,
                  jnp.ones((H_A, 1), jnp.float32), (D_NOPE + D_ROPE) ** -0.5)
    lam_init = 0.8 - 0.6 * math.exp(-0.3 * layer_idx)
    f32 = jnp.float32
    lam = (jnp.exp(jnp.sum(lp['lambda_q1'].astype(f32) * lp['lambda_k1'].astype(f32)))
           - jnp.exp(jnp.sum(lp['lambda_q2'].astype(f32) * lp['lambda_k2'].astype(f32))) + lam_init)
    coef = jnp.broadcast_to(jnp.stack([jnp.ones_like(lam), -lam]), (H_B, 2))
    slopes = jnp.asarray(_alibi_slopes(H_B))
    o_b = _attend(dq, dk_all, dv_all, pos, k_pos, slopes, coef, D_HB ** -0.5)
    o_b = _rms(o_b, lp['g_subln']) * (1.0 - lam_init)
    mix = jnp.concatenate([o_a.reshape(b, s, H_A * D_VA), o_b.reshape(b, s, W_B)], -1)
    return mix @ lp['w_o'], (c_kv, k_r, dk, dv)


def _conv_ffn(h, conv_state, lp):
    b, s, _ = h.shape
    u = h @ lp['w_up']
    if conv_state is None:
        conv_state = jnp.zeros((b, CONV_W - 1, 2 * D_FF), u.dtype)
    up = jnp.concatenate([conv_state, u], 1)
    z = lp['conv_b'] + sum(up[:, j:j + s] * lp['conv_w'][j] for j in range(CONV_W))
    g, v = z[..., :D_FF], z[..., D_FF:]
    out = (jax.nn.gelu(g, approximate=False) * v) @ lp['w_down']
    return out, up[:, -(CONV_W - 1):]


def _layer(x, p_emb, pos, past, conv_state, lp, layer_idx):
    a, rows = _token_mixers(x, pos, past, lp, layer_idx)
    h = _ln(ALPHA * x + a, lp['ln1_g'], lp['ln1_b'])
    f, new_conv = _conv_ffn(h, conv_state, lp)
    h = _ln(ALPHA * h + f, lp['ln2_g'], lp['ln2_b'])
    gate = jax.nn.sigmoid(h @ lp['w_ple_gate'] + lp['b_ple_gate'])
    y = h + gate * (p_emb @ lp['w_ple_proj'])
    return y, rows + (new_conv,)


def setup_inputs(seed: int = 0) -> dict:
    key = jax.random.key(seed)
    ks = iter(jax.random.split(key, 48))

    def nrm(shape, scale=1.0):
        return jax.random.normal(next(ks), shape, jnp.float32) * scale

    L = DEPTH
    w_in = jnp.concatenate([nrm((L, D_MODEL, D_CQ + D_CKV + D_ROPE + 2 * W_B), D_MODEL ** -0.5),
                            nrm((L, D_MODEL, W_B), BETA * D_MODEL ** -0.5)], -1)
    return {
        'x_prompt': nrm((BATCH, SEQ, D_MODEL)),
        'x_sample': nrm((DEC_BATCH, DEC_SEQ, D_MODEL)),
        'cache_ckv': nrm((L, DEC_BATCH, PAST_LEN, D_CKV)),
        'cache_krope': nrm((L, DEC_BATCH, PAST_LEN, D_ROPE)),
        'cache_diff_k': nrm((L, DEC_BATCH, PAST_LEN, H_B, 2, D_HB)),
        'cache_diff_v': nrm((L, DEC_BATCH, PAST_LEN, H_B, 2 * D_HB), BETA),
        'state_ffn_conv': nrm((L, DEC_BATCH, CONV_W - 1, 2 * D_FF)),
        'p_prompt': nrm((L, BATCH, SEQ, D_PLE)),
        'p_sample': nrm((L, DEC_BATCH, DEC_SEQ, D_PLE)),
        'w_in': w_in,
        'g_cq': 1.0 + nrm((L, D_CQ), 0.01),
        'w_uq': nrm((L, D_CQ, H_A * (D_NOPE + D_ROPE)), D_CQ ** -0.5),
        'g_ckv': 1.0 + nrm((L, D_CKV), 0.01),
        'w_uk': nrm((L, D_CKV, H_A * D_NOPE), D_CKV ** -0.5),
        'w_uv': nrm((L, D_CKV, H_A * D_VA), BETA * D_CKV ** -0.5),
        'lambda_q1': nrm((L, D_HB), 0.1),
        'lambda_k1': nrm((L, D_HB), 0.1),
        'lambda_q2': nrm((L, D_HB), 0.1),
        'lambda_k2': nrm((L, D_HB), 0.1),
        'g_subln': 1.0 + nrm((L, 2 * D_HB), 0.01),
        'w_o': nrm((L, D_MIX, D_MODEL), BETA * D_MIX ** -0.5),
        'ln1_g': 1.0 + nrm((L, D_MODEL), 0.01),
        'ln1_b': nrm((L, D_MODEL), 0.01),
        'w_up': nrm((L, D_MODEL, 2 * D_FF), D_MODEL ** -0.5),
        'conv_w': nrm((L, CONV_W, 2 * D_FF), CONV_W ** -0.5),
        'conv_b': nrm((L, 2 * D_FF), 0.01),
        'w_down': nrm((L, D_FF, D_MODEL), BETA * D_FF ** -0.5),
        'ln2_g': 1.0 + nrm((L, D_MODEL), 0.01),
        'ln2_b': nrm((L, D_MODEL), 0.01),
        'w_ple_gate': nrm((L, D_MODEL, D_MODEL), D_MODEL ** -0.5),
        'b_ple_gate': nrm((L, D_MODEL), 0.01),
        'w_ple_proj': nrm((L, D_PLE, D_MODEL), D_PLE ** -0.5),
    }


def reference(x_prompt, x_sample, cache_ckv, cache_krope, cache_diff_k, cache_diff_v, state_ffn_conv,
              p_prompt, p_sample, w_in, g_cq, w_uq, g_ckv, w_uk, w_uv, lambda_q1, lambda_k1,
              lambda_q2, lambda_k2, g_subln, w_o, ln1_g, ln1_b, w_up, conv_w, conv_b, w_down,
              ln2_g, ln2_b, w_ple_gate, b_ple_gate, w_ple_proj):
    past_len = cache_ckv.shape[2]
    pos_p = jnp.arange(x_prompt.shape[1])
    pos_s = past_len + jnp.arange(x_sample.shape[1])
    y_p, y_s = x_prompt, x_sample
    new_p, new_s = [], []
    for i in range(DEPTH):
        lp = {'w_in': w_in[i], 'g_cq': g_cq[i], 'w_uq': w_uq[i], 'g_ckv': g_ckv[i], 'w_uk': w_uk[i],
              'w_uv': w_uv[i], 'lambda_q1': lambda_q1[i], 'lambda_k1': lambda_k1[i],
              'lambda_q2': lambda_q2[i], 'lambda_k2': lambda_k2[i], 'g_subln': g_subln[i],
              'w_o': w_o[i], 'ln1_g': ln1_g[i], 'ln1_b': ln1_b[i], 'w_up': w_up[i],
              'conv_w': conv_w[i], 'conv_b': conv_b[i], 'w_down': w_down[i], 'ln2_g': ln2_g[i],
              'ln2_b': ln2_b[i], 'w_ple_gate': w_ple_gate[i], 'b_ple_gate': b_ple_gate[i],
              'w_ple_proj': w_ple_proj[i]}
        y_p, st_p = _layer(y_p, p_prompt[i], pos_p, None, None, lp, i)
        past = (cache_ckv[i], cache_krope[i], cache_diff_k[i], cache_diff_v[i])
        y_s, st_s = _layer(y_s, p_sample[i], pos_s, past, state_ffn_conv[i], lp, i)
        new_p.append(st_p)
        new_s.append(st_s)
    sp = [jnp.stack([st[j] for st in new_p]) for j in range(5)]
    ss = [jnp.stack([st[j] for st in new_s]) for j in range(5)]
    return (y_p, y_s, sp[0], sp[1], sp[2], sp[3], sp[4], ss[0], ss[1], ss[2], ss[3], ss[4])
```

```cpp
#include <hip/hip_runtime.h>
#include <hip/hip_cooperative_groups.h>
#include <cstdio>
#include <cstdint>
namespace cg = cooperative_groups;

#ifndef N_LAUNCH_MODE
#define N_LAUNCH_MODE 1
#endif

#ifndef P7_REPEAT
#define P7_REPEAT 1
#endif
#ifndef P4_REPEAT
#define P4_REPEAT 1
#endif
#define LAS __attribute__((address_space(3)))
typedef unsigned short bf16_t;
typedef short bf16x8 __attribute__((ext_vector_type(8)));
typedef short s16x4 __attribute__((ext_vector_type(4)));
typedef float f32x4 __attribute__((ext_vector_type(4)));
typedef float f32x2 __attribute__((ext_vector_type(2)));
typedef float f32x16 __attribute__((ext_vector_type(16)));
typedef unsigned u32x4 __attribute__((ext_vector_type(4)));
typedef unsigned u32x2 __attribute__((ext_vector_type(2)));

constexpr int TP = 65536, TS = 1024, T = TP + TS;
constexpr int SEQ = 2048, DSEQ = 32, PAST = 2048, SK = 2080;
constexpr int DM = 1024, NIN = 2304, DFF = 2816, DFF2 = 5632;
constexpr float ALPHA = 1.189207115002721f;
constexpr float EPS = 1e-5f;
constexpr float L2E = 1.4426950408889634f;

constexpr size_t MiB = 1u << 20;
constexpr size_t WS_CTL = 0, WS_ROPE = 64 * 1024, WS_CTAB = 576 * 1024;
constexpr size_t WS_WIN = 1 * MiB, WS_WUQ = 6 * MiB, WS_WUKV = 6 * MiB + 512 * 1024, WS_WO = 7 * MiB, WS_WUP = 9 * MiB, WS_WDN = 20 * MiB, WS_WG = 26 * MiB, WS_WPP = 28 * MiB;
constexpr size_t WS_PB = 32 * MiB, WS_PROJ = 65 * MiB, WS_H = 65 * MiB, WS_XB = 358 * MiB, WS_CQB = 358 * MiB, WS_CALLP = 391 * MiB, WS_CALLS = 423 * MiB;
constexpr size_t WS_MIX = 358 * MiB, WS_PP = 358 * MiB, WS_DKS = 488 * MiB, WS_DVS = 554 * MiB, WS_QA = 620 * MiB, WS_KVP = 718 * MiB, WS_KVS = 846 * MiB;
constexpr size_t WS_KRBP = 977 * MiB, WS_KRBS = 981 * MiB, WS_H1B = 488 * MiB, WS_ACT = 620 * MiB, WS_H2B = 488 * MiB, WS_PARK = 986 * MiB, WS_USPEC = 1018 * MiB, WS_END = 1024 * MiB;

constexpr int NWAVES = 8, NTHR = 512;
constexpr int LDS_BYTES = 131072 + 4096;

__constant__ float ROPE_INV[16] = {1.0f, 0.5623413324356079f, 0.3162277638912201f, 0.17782793939113617f, 0.10000000149011612f, 0.05623412877321243f, 0.03162277862429619f,
    0.017782794311642647f, 0.009999999776482582f, 0.005623413249850273f, 0.003162277862429619f, 0.0017782794311642647f, 0.0010000000474974513f, 0.000562341301701963f,
    0.0003162277862429619f, 0.00017782794020604342f};

__device__ __forceinline__ unsigned pk2(float lo, float hi) { typedef __bf16 bf2 __attribute__((ext_vector_type(2))); f32x2 v = {lo, hi}; bf2 b = __builtin_convertvector(v, bf2); return __builtin_bit_cast(unsigned, b); }
__device__ __forceinline__ float bflo(unsigned u) { return __uint_as_float(u << 16); }
__device__ __forceinline__ float bfhi(unsigned u) { return __uint_as_float(u & 0xffff0000u); }
__device__ __forceinline__ float wave_sum(float v) {
#pragma unroll
    for (int o = 1; o < 64; o <<= 1) v += __shfl_xor(v, o);
    return v;
}
#define LDS_WAIT() asm volatile("s_waitcnt lgkmcnt(0)" ::: "memory")
__device__ __forceinline__ int lane_id() { int l; asm volatile("v_mbcnt_lo_u32_b32 %0, -1, 0\n\tv_mbcnt_hi_u32_b32 %0, -1, %0" : "=v"(l)); return l; }
__device__ __forceinline__ f32x2 gelu_pk(f32x2 v) {
    const f32x2 av = __builtin_elementwise_abs(v), d = av * 0.2316418882f + 1.0f;
    f32x2 t; t.x = __builtin_amdgcn_rcpf(d.x); t.y = __builtin_amdgcn_rcpf(d.y);
    f32x2 q = t * 0.5307027145f + (-0.7265760135f); q = q * t + 0.7107068705f; q = q * t + (-0.142248368f); q = q * t + 0.127414796f; q = q * t;
    const f32x2 s = (v * v) * (-0.72134752044f);
    f32x2 e; e.x = __builtin_amdgcn_exp2f(s.x); e.y = __builtin_amdgcn_exp2f(s.y);
    const f32x2 m = v * (q * e), r = v - m;
    f32x2 o; o.x = v.x < 0.f ? m.x : r.x; o.y = v.y < 0.f ? m.y : r.y; return o;
}

namespace pg8 {
constexpr int BM = 256, BK = 64, HALF = 128, HTB = HALF * BK * 2, STAGE_BYTES = 8 * HTB, NXCD = 8, WGM = 8;
__device__ __forceinline__ int lds_byte(int r, int c) { const int st = (r >> 4) * 2 + (c >> 5), rr = r & 15, cc = c & 31, ob = rr * 64 + cc * 2; return st * 1024 + (ob ^ (((ob >> 9) & 1) << 5)); }
__device__ __forceinline__ void stage_rc(int b, int& R, int& C) { const int st = b / 1024, sb = b % 1024, swz = sb ^ (((sb >> 9) & 1) << 5); R = (st >> 1) * 16 + swz / 64; C = (st & 1) * 32 + (swz % 64) / 2; }
__device__ __forceinline__ int perm32(int rho) { const int n = rho >> 4, i = rho & 15; return 8 * (i >> 2) + 4 * n + (i & 3); }

struct Unit { int pm, pn; };
struct Gemm { const bf16_t* A; const bf16_t* Bt; int lda, K; };

struct StaticOrder {
    int nM, nN, nwg, G, c;
    __device__ void init(int nM_, int nN_, int G_, int c_) { nM = nM_; nN = nN_; nwg = nM * nN; G = G_; c = c_; }
    __device__ bool next(int i, Unit& u) const {
        const long L = (long)i * G + c; if (L >= nwg) return false;
        int wgid = (int)L; { const int q = nwg / NXCD, r = nwg % NXCD, xcd = wgid % NXCD, off = wgid / NXCD; wgid = (xcd < r ? xcd * (q + 1) : r * (q + 1) + (xcd - r) * q) + off; }
        const int nig = WGM * nN, gid = wgid / nig, fm = gid * WGM, gsz = (nM - fm) < WGM ? (nM - fm) : WGM;
        u.pm = fm + ((wgid % nig) % gsz); u.pn = (wgid % nig) / gsz; return true;
    }
};

template <class Epi, int AMAP>
__device__ __forceinline__ void gemm_phase(LAS unsigned char* lds, const Gemm g, const StaticOrder& S, const Epi& E, int wid) {
    const int lane = lane_id(), tid = wid * 64 + lane, wr = wid >> 2, wc = wid & 3, fr = lane & 15, fq = lane >> 4;
    const int K = g.K, nt = K / BK, lda = g.lda;
    unsigned voffA[2], voffB[2];
#pragma unroll
    for (int i = 0; i < 2; ++i) { int R, C; stage_rc(tid * 16 + i * 8192, R, C); const int Rb = (R & ~31) + perm32(R & 31);
        const int Ra = AMAP == 0 ? R : (126 * (R >> 6) + 8 * (R & 15) + ((R >> 4) & 3));
        voffA[i] = (unsigned)(Ra * lda + C) * 2u; voffB[i] = (unsigned)(Rb * K + C) * 2u; }
    const size_t kstep = (size_t)(BK * 2);
    const size_t hstepA = AMAP == 0 ? (size_t)HALF * lda * 2 : (size_t)4 * lda * 2;
    const size_t tstepA = AMAP == 0 ? (size_t)BM * lda * 2 : (size_t)252 * lda * 2;
    const size_t hstepB = (size_t)HALF * K * 2, tstepB = 2 * hstepB;
    const unsigned ldsw = (unsigned)wid * 1024u;
    const int aoff = lds_byte(wr * 64 + fr, fq * 8), boff = lds_byte(wc * 32 + fr, fq * 8);
#define PG8_SA(b, h) (((b) * 2 + (h)) * HTB)
#define PG8_SB(b, h) ((4 + (b) * 2 + (h)) * HTB)
#define PG8_STAGE(bufoff, gbase, voff) do { _Pragma("unroll") for (int _i = 0; _i < 2; ++_i) \
        __builtin_amdgcn_global_load_lds((const unsigned*)((const char*)(gbase) + (voff)[_i]), (LAS unsigned*)(lds + (bufoff) + ldsw + _i * 8192), 16, 0, 0); } while (0)
#define PG8_LDA(dst, b, h) do { _Pragma("unroll") for (int m = 0; m < 4; ++m) _Pragma("unroll") for (int k = 0; k < 2; ++k) dst[m][k] = *(const LAS bf16x8*)(lds + PG8_SA(b, h) + aoff + m * 2048 + k * 1024); } while (0)
#define PG8_LDB(dst, b, h) do { _Pragma("unroll") for (int n = 0; n < 2; ++n) _Pragma("unroll") for (int k = 0; k < 2; ++k) dst[n][k] = *(const LAS bf16x8*)(lds + PG8_SB(b, h) + boff + n * 2048 + k * 1024); } while (0)
#define PG8_MMA(ai, bj, At, Bt) do { __builtin_amdgcn_s_setprio(1); _Pragma("unroll") for (int m = 0; m < 4; ++m) _Pragma("unroll") for (int n = 0; n < 2; ++n) _Pragma("unroll") for (int k = 0; k < 2; ++k) \
        acc[ai][bj][m][n] = __builtin_amdgcn_mfma_f32_16x16x32_bf16(Bt[n][k], At[m][k], acc[ai][bj][m][n], 0, 0, 0); __builtin_amdgcn_s_setprio(0); } while (0)
#define PG8_WAIT_V(n) asm volatile("s_waitcnt vmcnt(" #n ")" ::: "memory")
#define PG8_WAIT_L(n) asm volatile("s_waitcnt lgkmcnt(" #n ")" ::: "memory")
#define PG8_BAR __builtin_amdgcn_s_barrier()
#define PG8_SCHED __builtin_amdgcn_sched_barrier(0)
    Unit cur, nxt; int ui = 0;
    if (!S.next(0, cur)) return;
    f32x4 acc[2][2][4][2];
#pragma unroll
    for (int a = 0; a < 2; ++a)
#pragma unroll
        for (int b = 0; b < 2; ++b)
#pragma unroll
            for (int m = 0; m < 4; ++m)
#pragma unroll
                for (int n = 0; n < 2; ++n) acc[a][b][m][n] = (f32x4){0.f, 0.f, 0.f, 0.f};
    bf16x8 At[4][2], B0[2][2], B1[2][2];
    const char* cA = (const char*)g.A + (size_t)cur.pm * tstepA; const char* cB = (const char*)g.Bt + (size_t)cur.pn * tstepB;
    PG8_STAGE(PG8_SB(0, 0), cB, voffB); PG8_STAGE(PG8_SB(0, 1), cB + hstepB, voffB); PG8_STAGE(PG8_SA(0, 0), cA, voffA); PG8_STAGE(PG8_SA(0, 1), cA + hstepA, voffA);
    if (wr == 1) PG8_BAR;
    PG8_WAIT_V(2); PG8_BAR;
    PG8_STAGE(PG8_SB(1, 0), cB + kstep, voffB); PG8_STAGE(PG8_SA(1, 0), cA + kstep, voffA); PG8_STAGE(PG8_SB(1, 1), cB + hstepB + kstep, voffB);
    PG8_WAIT_V(6); PG8_BAR;
    for (;;) {
        const bool has_next = S.next(ui + 1, nxt);
        const char* nA = has_next ? (const char*)g.A + (size_t)nxt.pm * tstepA : cA; const char* nB = has_next ? (const char*)g.Bt + (size_t)nxt.pn * tstepB : cB;
#pragma unroll 1
        for (int t = 0; t < nt; t += 2) {
            const bool last = (t == nt - 2);
            const char* a1 = cA + (size_t)(t + 1) * kstep;
            const char* a2 = last ? nA : cA + (size_t)(t + 2) * kstep; const char* b2 = last ? nB : cB + (size_t)(t + 2) * kstep;
            const char* a3 = a2 + kstep; const char* b3 = b2 + kstep;
            PG8_LDB(B0, 0, 0); PG8_LDB(B1, 0, 1); PG8_SCHED; PG8_LDA(At, 0, 0); PG8_STAGE(PG8_SA(1, 1), a1 + hstepA, voffA);
            PG8_WAIT_V(8); PG8_WAIT_L(0); PG8_BAR; PG8_MMA(0, 0, At, B0); PG8_MMA(0, 1, At, B1); PG8_BAR; PG8_SCHED;
            PG8_LDA(At, 0, 1); PG8_STAGE(PG8_SB(0, 0), b2, voffB); PG8_STAGE(PG8_SB(0, 1), b2 + hstepB, voffB); PG8_STAGE(PG8_SA(0, 0), a2, voffA);
            PG8_WAIT_V(8); PG8_WAIT_L(0); PG8_BAR; PG8_MMA(1, 0, At, B0); PG8_MMA(1, 1, At, B1); PG8_BAR; PG8_SCHED;
            PG8_LDB(B0, 1, 0); PG8_LDB(B1, 1, 1); PG8_SCHED; PG8_LDA(At, 1, 0); PG8_STAGE(PG8_SA(0, 1), a2 + hstepA, voffA);
            PG8_WAIT_V(8); PG8_WAIT_L(0); PG8_BAR; PG8_MMA(0, 0, At, B0); PG8_MMA(0, 1, At, B1); PG8_BAR; PG8_SCHED;
            PG8_LDA(At, 1, 1); PG8_STAGE(PG8_SB(1, 0), b3, voffB); PG8_STAGE(PG8_SB(1, 1), b3 + hstepB, voffB); PG8_STAGE(PG8_SA(1, 0), a3, voffA);
            PG8_WAIT_V(8); PG8_WAIT_L(0); PG8_BAR; PG8_MMA(1, 0, At, B0); PG8_MMA(1, 1, At, B1); PG8_BAR; PG8_SCHED;
        }
        if (wr == 0) PG8_BAR;
        E(acc, cur, wr, wc, fr, fq);
        if (!has_next) break;
#pragma unroll
        for (int a = 0; a < 2; ++a)
#pragma unroll
            for (int b = 0; b < 2; ++b)
#pragma unroll
                for (int m = 0; m < 4; ++m)
#pragma unroll
                    for (int n = 0; n < 2; ++n) acc[a][b][m][n] = (f32x4){0.f, 0.f, 0.f, 0.f};
        cur = nxt; cA = nA; cB = nB; ++ui;
        if (wr == 1) PG8_BAR;
    }
    PG8_WAIT_V(0);
    PG8_BAR;
#undef PG8_SA
#undef PG8_SB
#undef PG8_STAGE
#undef PG8_LDA
#undef PG8_LDB
#undef PG8_MMA
#undef PG8_WAIT_V
#undef PG8_WAIT_L
#undef PG8_BAR
#undef PG8_SCHED
}

struct EpiBf16 {
    bf16_t* O; int ldc;
    __device__ __forceinline__ void operator()(f32x4 (&acc)[2][2][4][2], const Unit& u, int wr, int wc, int fr, int fq) const {
        const int row0 = u.pm * BM + wr * 64 + fr, col0 = u.pn * BM + wc * 32 + 8 * fq;
#pragma unroll
        for (int ai = 0; ai < 2; ++ai)
#pragma unroll
            for (int m = 0; m < 4; ++m) { bf16_t* rowp = O + (size_t)(row0 + ai * HALF + m * 16) * ldc + col0;
#pragma unroll
                for (int bj = 0; bj < 2; ++bj) { const f32x4 v0 = acc[ai][bj][m][0], v1 = acc[ai][bj][m][1];
                    u32x4 w; w.x = pk2(v0[0], v0[1]); w.y = pk2(v0[2], v0[3]); w.z = pk2(v1[0], v1[1]); w.w = pk2(v1[2], v1[3]);
                    *(u32x4*)(rowp + bj * HALF) = w; } }
    }
};
struct EpiProj {
    bf16_t* O; float* dkp; float* dks_o; float* dvp; float* dvs_o;
    __device__ __forceinline__ void operator()(f32x4 (&acc)[2][2][4][2], const Unit& u, int wr, int wc, int fr, int fq) const {
        const int row0 = u.pm * BM + wr * 64 + fr, col0 = u.pn * BM + wc * 32 + 8 * fq;
        float* fo = nullptr;
        if (u.pn >= 4 && u.pn < 8) { const bool samp = u.pm * BM >= TP; const int c0 = col0 - (u.pn < 6 ? 1024 : 1536);
            fo = (u.pn < 6 ? (samp ? dks_o - (size_t)TP * 512 : dkp) : (samp ? dvs_o - (size_t)TP * 512 : dvp)) + c0; }
#pragma unroll
        for (int ai = 0; ai < 2; ++ai)
#pragma unroll
            for (int m = 0; m < 4; ++m) { const int row = row0 + ai * HALF + m * 16; bf16_t* rowp = O + (size_t)row * NIN + col0;
#pragma unroll
                for (int bj = 0; bj < 2; ++bj) { const f32x4 v0 = acc[ai][bj][m][0], v1 = acc[ai][bj][m][1];
                    u32x4 w; w.x = pk2(v0[0], v0[1]); w.y = pk2(v0[2], v0[3]); w.z = pk2(v1[0], v1[1]); w.w = pk2(v1[2], v1[3]);
                    *(u32x4*)(rowp + bj * HALF) = w; } }
        if (fo) {
            asm volatile("" ::: "memory");
#pragma unroll
            for (int ai = 0; ai < 2; ++ai)
#pragma unroll
                for (int m = 0; m < 4; ++m) { float* fp = fo + (size_t)(row0 + ai * HALF + m * 16) * 512;
#pragma unroll
                    for (int bj = 0; bj < 2; ++bj) { *(f32x4*)(fp + bj * HALF) = acc[ai][bj][m][0]; *(f32x4*)(fp + bj * HALF + 4) = acc[ai][bj][m][1]; }
                    if (m & 1) asm volatile("" ::: "memory"); }
        }
    }
};
struct EpiResX {
    const float* xp; const float* xs; float* h;
    __device__ __forceinline__ void operator()(f32x4 (&acc)[2][2][4][2], const Unit& u, int wr, int wc, int fr, int fq) const {
        const int row0 = u.pm * BM + wr * 64 + fr, col0 = u.pn * BM + wc * 32 + 8 * fq;
        const float* xb = (u.pm * BM < TP) ? xp : xs - (size_t)TP * DM;
#pragma unroll
        for (int ai = 0; ai < 2; ++ai)
#pragma unroll
            for (int m = 0; m < 4; ++m) { const size_t off = (size_t)(row0 + ai * HALF + m * 16) * DM + col0;
#pragma unroll
                for (int bj = 0; bj < 2; ++bj) {
                    const f32x4 x0 = *(const f32x4*)(xb + off + bj * HALF), x1 = *(const f32x4*)(xb + off + bj * HALF + 4);
                    *(f32x4*)(h + off + bj * HALF) = x0 * ALPHA + acc[ai][bj][m][0]; *(f32x4*)(h + off + bj * HALF + 4) = x1 * ALPHA + acc[ai][bj][m][1]; } }
    }
};
struct EpiResH {
    float* h; const float* stat; const float* g; const float* bt;
    __device__ __forceinline__ void operator()(f32x4 (&acc)[2][2][4][2], const Unit& u, int wr, int wc, int fr, int fq) const {
        const int row0 = u.pm * BM + wr * 64 + fr, col0 = u.pn * BM + wc * 32 + 8 * fq;
#pragma unroll
        for (int bj = 0; bj < 2; ++bj) {
            const f32x4 g0 = *(const f32x4*)(g + col0 + bj * HALF), g1 = *(const f32x4*)(g + col0 + bj * HALF + 4), b0 = *(const f32x4*)(bt + col0 + bj * HALF), b1 = *(const f32x4*)(bt + col0 + bj * HALF + 4);
#pragma unroll
            for (int ai = 0; ai < 2; ++ai)
#pragma unroll
                for (int m = 0; m < 4; ++m) { const int row = row0 + ai * HALF + m * 16; const size_t off = (size_t)row * DM + col0 + bj * HALF;
                    const f32x2 st = *(const f32x2*)(stat + 2 * (size_t)row);
                    const f32x4 x0 = *(const f32x4*)(h + off), x1 = *(const f32x4*)(h + off + 4);
                    *(f32x4*)(h + off) = ((x0 - st.x) * st.y * g0 + b0) * ALPHA + acc[ai][bj][m][0]; *(f32x4*)(h + off + 4) = ((x1 - st.x) * st.y * g1 + b1) * ALPHA + acc[ai][bj][m][1]; }
        }
    }
};
struct EpiGate {
    const float* h2; const bf16_t* pp; const float* bias; float* yp; float* ys; const float* stat; const float* g; const float* bt;
    __device__ __forceinline__ void operator()(f32x4 (&acc)[2][2][4][2], const Unit& u, int wr, int wc, int fr, int fq) const {
        const int row0 = u.pm * BM + wr * 64 + fr, col0 = u.pn * BM + wc * 32 + 8 * fq;
        float* yb = (u.pm * BM < TP) ? yp : ys - (size_t)TP * DM;
#pragma unroll
        for (int bj = 0; bj < 2; ++bj) {
            const f32x4 b0 = *(const f32x4*)(bias + col0 + bj * HALF), b1 = *(const f32x4*)(bias + col0 + bj * HALF + 4);
            const f32x4 lg0 = *(const f32x4*)(g + col0 + bj * HALF), lg1 = *(const f32x4*)(g + col0 + bj * HALF + 4), lb0 = *(const f32x4*)(bt + col0 + bj * HALF), lb1 = *(const f32x4*)(bt + col0 + bj * HALF + 4);
#pragma unroll
            for (int ai = 0; ai < 2; ++ai)
#pragma unroll
                for (int m = 0; m < 4; ++m) { const int row = row0 + ai * HALF + m * 16; const size_t off = (size_t)row * DM + col0 + bj * HALF;
                    const f32x2 st = *(const f32x2*)(stat + 2 * (size_t)row);
                    const f32x4 h0 = (*(const f32x4*)(h2 + off) - st.x) * st.y * lg0 + lb0, h1 = (*(const f32x4*)(h2 + off + 4) - st.x) * st.y * lg1 + lb1;
                    const u32x4 pw = *(const u32x4*)(pp + off);
                    const f32x4 p0 = {bflo(pw.x), bfhi(pw.x), bflo(pw.y), bfhi(pw.y)}, p1 = {bflo(pw.z), bfhi(pw.z), bflo(pw.w), bfhi(pw.w)};
                    f32x4 g0 = acc[ai][bj][m][0] + b0, g1 = acc[ai][bj][m][1] + b1;
#pragma unroll
                    for (int e = 0; e < 4; ++e) { g0[e] = __builtin_amdgcn_rcpf(1.f + __builtin_amdgcn_exp2f(-g0[e] * L2E)); g1[e] = __builtin_amdgcn_rcpf(1.f + __builtin_amdgcn_exp2f(-g1[e] * L2E)); }
                    *(f32x4*)(yb + off) = h0 + g0 * p0; *(f32x4*)(yb + off + 4) = h1 + g1 * p1; }
        }
    }
};
__device__ __forceinline__ float dpp_shr1(float v) { float r; asm volatile("s_nop 1\n\tv_mov_b32_dpp %0, %1 row_shr:1 row_mask:0xf bank_mask:0xf\n\ts_nop 1" : "=v"(r) : "v"(v)); return r; }
struct EpiConvGlu {
    bf16_t* act; const float* ctab; float* uspec;
    __device__ __forceinline__ void operator()(f32x4 (&acc)[2][2][4][2], const Unit& u, int wr, int wc, int fr, int fq) const {
        const int tok0 = 252 * u.pm + 126 * wr - 2 + 8 * fr;
        const int j0 = 128 * u.pn + 32 * wc + 8 * fq;
        const int x = tok0 - 1;
        const int rem = x < TP ? ((2048 - (x & 2047)) & 2047) : ((32 - ((x - TP) & 31)) & 31);
        const int s = x + rem; int ks = rem - 1; if (ks > 9 || s > T) ks = 100;
        const int kmin = fr == 0 ? 2 : 0, kmax = T - tok0;
        if (ks <= 9) {
            const int si = s <= TP ? (s >> 11) : 32 + ((s - TP) >> 5);
            float* o = uspec + (size_t)si * 4 * DFF2 + j0;
#pragma unroll
            for (int k = 0; k < 8; ++k) { const int d = k - ks + 2;
                if (k >= kmin && k < kmax && (unsigned)d < 4u) { float* od = o + (size_t)d * DFF2;
                    *(f32x4*)od = acc[k >> 2][0][k & 3][0]; *(f32x4*)(od + 4) = acc[k >> 2][0][k & 3][1]; *(f32x4*)(od + DFF) = acc[k >> 2][1][k & 3][0]; *(f32x4*)(od + DFF + 4) = acc[k >> 2][1][k & 3][1]; } }
        }
        asm volatile("" ::: "memory");
#pragma unroll
        for (int n = 0; n < 2; ++n) {
            const f32x4* tab = (const f32x4*)(ctab + (size_t)(j0 + 4 * n) * 8);
            const f32x4 wg0 = tab[0], wg1 = tab[1], wg2 = tab[2], bg = tab[3], wv0 = tab[4], wv1 = tab[5], wv2 = tab[6], bv = tab[7];
            f32x4 p1g, p2g, p1v, p2v;
#pragma unroll
            for (int e = 0; e < 4; ++e) { p1g[e] = dpp_shr1(acc[1][0][3][n][e]); p2g[e] = dpp_shr1(acc[1][0][2][n][e]); p1v[e] = dpp_shr1(acc[1][1][3][n][e]); p2v[e] = dpp_shr1(acc[1][1][2][n][e]); }
#pragma unroll
            for (int k = 0; k < 8; ++k) {
                const f32x4 cg = acc[k >> 2][0][k & 3][n], cv = acc[k >> 2][1][k & 3][n];
                const f32x4 zg = bg + wg0 * p2g + wg1 * p1g + wg2 * cg, zv = bv + wv0 * p2v + wv1 * p1v + wv2 * cv;
                p2g = p1g; p1g = cg; p2v = p1v; p1v = cv;
                const f32x2 r0 = gelu_pk((f32x2){zg[0], zg[1]}) * (f32x2){zv[0], zv[1]}, r1 = gelu_pk((f32x2){zg[2], zg[3]}) * (f32x2){zv[2], zv[3]};
                if (k >= kmin && k < kmax && (unsigned)(k - ks) >= 2u) {
                    u32x2 w; w.x = pk2(r0.x, r0.y); w.y = pk2(r1.x, r1.y);
                    *(u32x2*)(act + (size_t)(tok0 + k) * DFF + j0 + 4 * n) = w; }
            }
            asm volatile("" ::: "memory");
        }
    }
};
}

#define MFMA32(a, b, c) __builtin_amdgcn_mfma_f32_32x32x16_bf16((a), (b), (c), 0, 0, 0)
__device__ __forceinline__ float max3f(float a, float b, float c) { float r; asm("v_max3_f32 %0, %1, %2, %3" : "=v"(r) : "v"(a), "v"(b), "v"(c)); return r; }
__device__ __forceinline__ float max2f(float a, float b) { float r; asm("v_max_f32_e32 %0, %1, %2" : "=v"(r) : "v"(a), "v"(b)); return r; }
__device__ __forceinline__ float shfl32(float v) { return __int_as_float(__builtin_amdgcn_ds_bpermute((lane_id() ^ 32) << 2, __float_as_int(v))); }
__device__ __forceinline__ int crow(int r, int hi) { return (r & 3) + 8 * (r >> 2) + 4 * hi; }
__device__ __forceinline__ bf16x8 pack8(const f32x16& p, int o) {
    u32x4 w; w.x = pk2(p[o], p[o + 1]); w.y = pk2(p[o + 2], p[o + 3]); w.z = pk2(p[o + 4], p[o + 5]); w.w = pk2(p[o + 6], p[o + 7]); return __builtin_bit_cast(bf16x8, w);
}
template <int DK, int DV, bool MLA, bool ALIBI, bool QL>
__device__ __forceinline__ void flash_pass(LAS unsigned char* lds, const bf16x8 (&qf)[DK / 16], const bf16_t* Kg, int kpitch, const bf16_t* KRg, const bf16_t* Vg, int vpitch,
                                           int nt_unit, int nt_wave, int nvalid_last, float scale_l2e, float slope_l2e, int qpos, int kpos0, f32x16 (&O)[DV / 32], float& lsum, int wv) {
    constexpr int KP = DK * 2 + 16, VP = DV * 2 + 64, KBUF = 64 * KP, VBUF = 64 * VP, BUF = KBUF + VBUF, NV = DV / 64, VCH = DV / 8;
    const int lane = lane_id(), tid = wv * 64 + lane, r32 = lane & 31, hi = lane >> 5;
    const int krow = tid >> 3, kch = tid & 7, rrow = (tid & 255) >> 2, rch = tid & 3;
    const unsigned koffb = (unsigned)(krow * kpitch + kch * 8) * 2u, kroffb = (unsigned)(rrow * 32 + rch * 8) * 2u;
    unsigned voffb[NV];
#pragma unroll
    for (int i = 0; i < NV; ++i) { const int idx = tid + 512 * i; voffb[i] = (unsigned)((idx / VCH) * vpitch + (idx % VCH) * 8) * 2u; }
    u32x4 kreg[2], krreg[2] = {{0, 0, 0, 0}, {0, 0, 0, 0}}, vreg[2][NV];
#define FP_GLOAD(t, P) do { kreg[P] = *(const u32x4*)((const char*)Kg + (size_t)(t) * 128 * kpitch + koffb); if (MLA && tid < 256) krreg[P] = *(const u32x4*)((const char*)KRg + (size_t)(t) * 4096 + kroffb); \
        _Pragma("unroll") for (int _i = 0; _i < NV; ++_i) vreg[P][_i] = *(const u32x4*)((const char*)Vg + (size_t)(t) * 128 * vpitch + voffb[_i]); } while (0)
#define FP_LSTORE(buf, P) do { LAS unsigned char* kb_ = lds + (buf) * BUF; *(LAS u32x4*)(kb_ + krow * KP + kch * 16) = kreg[P]; if (MLA && tid < 256) *(LAS u32x4*)(kb_ + rrow * KP + 128 + rch * 16) = krreg[P]; \
        _Pragma("unroll") for (int _i = 0; _i < NV; ++_i) { const int idx = tid + 512 * _i; *(LAS u32x4*)(kb_ + KBUF + (idx / VCH) * VP + (idx % VCH) * 16) = vreg[P][_i]; } } while (0)
    float m = -1e30f, l = 0.f;
#pragma unroll
    for (int b = 0; b < DV / 32; ++b)
#pragma unroll
        for (int r = 0; r < 16; ++r) O[b][r] = 0.f;
    constexpr bool TWO = true;
    FP_GLOAD(0, 0); if (TWO && nt_unit > 1) FP_GLOAD(1, 1);
    FP_LSTORE(0, 0);
    LAS unsigned char* qlds = lds + 2 * BUF + wv * (DK / 16) * 1024 + lane * 16;
    if (QL) {
#pragma unroll
        for (int s = 0; s < DK / 16; ++s) *(LAS bf16x8*)(qlds + s * 1024) = qf[s];
    }
    __syncthreads();
    const int q4 = (lane & 15) >> 2, p4 = lane & 3, cg16 = (lane >> 4) & 1;
    for (int t2 = 0; t2 < nt_unit; t2 += 2)
#pragma unroll
    for (int par = 0; par < 2; ++par) {
        const int t = t2 + par;
        if (t >= nt_unit) break;
        const bool more = t + 1 < nt_unit;
        if (TWO) { if (t + 2 < nt_unit) FP_GLOAD(t + 2, par); }
        else { if (more) FP_GLOAD(t + 1, 0); }
        if (t < nt_wave) {
            LAS const unsigned char* kb = lds + (t & 1) * BUF; LAS const unsigned char* vb = kb + KBUF;
            constexpr int KH = (DV > 64) ? DK / 32 : DK / 16;
            bf16x8 kf[2 * KH];
#pragma unroll
            for (int s = 0; s < KH; ++s) { kf[2 * s] = *(LAS const bf16x8*)(kb + r32 * KP + s * 32 + hi * 16); kf[2 * s + 1] = *(LAS const bf16x8*)(kb + (32 + r32) * KP + s * 32 + hi * 16); }
            s16x4 vf[4][DV / 32][2];
            LAS const unsigned char* vad = vb + (4 * hi + q4) * VP + (16 * cg16) * 2 + 8 * p4;
#define FP_VLOAD(s) do { _Pragma("unroll") for (int b = 0; b < DV / 32; ++b) { vf[s][b][0] = __builtin_amdgcn_ds_read_tr16_b64_v4i16((LAS s16x4*)(vad + 16 * (s) * VP + 64 * b)); \
                vf[s][b][1] = __builtin_amdgcn_ds_read_tr16_b64_v4i16((LAS s16x4*)(vad + (16 * (s) + 8) * VP + 64 * b)); } } while (0)
            FP_VLOAD(0);
            __builtin_amdgcn_sched_barrier(0);
            f32x16 p0, p1;
#pragma unroll
            for (int r = 0; r < 16; ++r) { p0[r] = 0.f; p1[r] = 0.f; }
#pragma unroll
            for (int s = 0; s < KH; ++s) { const bf16x8 q = QL ? *(LAS const bf16x8*)(qlds + s * 1024) : qf[s]; p0 = MFMA32(kf[2 * s], q, p0); p1 = MFMA32(kf[2 * s + 1], q, p1); }
            if (KH < DK / 16) {
                __builtin_amdgcn_sched_barrier(0);
#pragma unroll
                for (int s = 0; s < KH; ++s) { kf[2 * s] = *(LAS const bf16x8*)(kb + r32 * KP + (s + KH) * 32 + hi * 16); kf[2 * s + 1] = *(LAS const bf16x8*)(kb + (32 + r32) * KP + (s + KH) * 32 + hi * 16); }
                __builtin_amdgcn_sched_barrier(0);
#pragma unroll
                for (int s = 0; s < KH; ++s) { const bf16x8 q = QL ? *(LAS const bf16x8*)(qlds + (s + KH) * 1024) : qf[s + KH]; p0 = MFMA32(kf[2 * s], q, p0); p1 = MFMA32(kf[2 * s + 1], q, p1); }
            }
            __builtin_amdgcn_sched_barrier(0);
            if (DV <= 64) FP_VLOAD(1);
            __builtin_amdgcn_sched_barrier(0);
            const int kbase = kpos0 + t * 64;
            if (ALIBI) {
                if (t < nt_wave - 1) {
                    const float cb = slope_l2e * (float)(kbase + 4 * hi - qpos);
#pragma unroll
                    for (int r = 0; r < 16; ++r) { const float bs = cb + slope_l2e * (float)((r & 3) + 8 * (r >> 2)); p0[r] = p0[r] * scale_l2e + bs; p1[r] = p1[r] * scale_l2e + (bs + 32.f * slope_l2e); }
                } else {
#pragma unroll
                    for (int r = 0; r < 16; ++r) { const int kp = kbase + crow(r, hi); p0[r] = p0[r] * scale_l2e - slope_l2e * fabsf((float)(qpos - kp)); p1[r] = p1[r] * scale_l2e - slope_l2e * fabsf((float)(qpos - kp - 32)); }
                }
            } else {
#pragma unroll
                for (int r = 0; r < 16; ++r) { p0[r] *= scale_l2e; p1[r] *= scale_l2e; }
            }
            if (nvalid_last < 64 && t == nt_unit - 1) {
                asm volatile("" ::: "memory");
#pragma unroll
                for (int r = 0; r < 16; ++r) { const int kv = crow(r, hi); if (kv >= nvalid_last) p0[r] = -INFINITY; if (kv + 32 >= nvalid_last) p1[r] = -INFINITY; }
            }
            float mx = max2f(p0[0], p1[0]);
#pragma unroll
            for (int r = 1; r < 16; ++r) mx = max3f(mx, p0[r], p1[r]);
            mx = max2f(mx, shfl32(mx));
            const float mnew = max2f(m, mx);
            if (__builtin_amdgcn_ballot_w64(mnew != m) != 0ull) {
                const float alpha = __builtin_amdgcn_exp2f(m - mnew); m = mnew; l *= alpha;
#pragma unroll
                for (int b = 0; b < DV / 32; ++b)
#pragma unroll
                    for (int r = 0; r < 16; ++r) O[b][r] *= alpha;
            }
            float rs = 0.f;
            __builtin_amdgcn_sched_barrier(0);
#pragma unroll
            for (int s = 0; s < 4; ++s) {
                if (DV <= 64) { if (s == 0) FP_VLOAD(2); if (s == 1) FP_VLOAD(3); }
                else { if (s == 0) FP_VLOAD(1); if (s == 1) FP_VLOAD(2); if (s == 2) FP_VLOAD(3); }
                float e[8];
#pragma unroll
                for (int i = 0; i < 8; ++i) { e[i] = __builtin_amdgcn_exp2f((s < 2 ? p0[8 * (s & 1) + i] : p1[8 * (s & 1) + i]) - m); rs += e[i]; }
                u32x4 pw; pw.x = pk2(e[0], e[1]); pw.y = pk2(e[2], e[3]); pw.z = pk2(e[4], e[5]); pw.w = pk2(e[6], e[7]);
                const bf16x8 pb = __builtin_bit_cast(bf16x8, pw);
#pragma unroll
                for (int b = 0; b < DV / 32; ++b) {
                    const bf16x8 va = __builtin_shufflevector(vf[s][b][0], vf[s][b][1], 0, 1, 2, 3, 4, 5, 6, 7);
                    O[b] = MFMA32(va, pb, O[b]);
                }
                __builtin_amdgcn_sched_barrier(0);
            }
            l += rs;
#undef FP_VLOAD
        }
        if (more) FP_LSTORE((t + 1) & 1, TWO ? (par ^ 1) : 0);
        __syncthreads();
    }
    lsum = l;
#undef FP_GLOAD
#undef FP_LSTORE
}

template <int DK, int DV, bool MLA, bool ALIBI>
__device__ __forceinline__ void sample_pass(LAS unsigned char* lds, const bf16x8 (&qf)[DK / 16], const bf16_t* Kg, int kpitch, const bf16_t* KRg, const bf16_t* Vg, int vpitch,
                                            float scale_l2e, float slope_l2e, int qpos, f32x16 (&O)[DV / 32], float& lsum, int wv) {
    constexpr int VP = DV * 2 + 64, VBYTES = 32 * VP, NVL = DV / 16, VCH = DV / 8, NB = DV / 32, DUMP = (NB * 16 + 2) * 256;
    const int lane = lane_id(), r32 = lane & 31, hi = lane >> 5;
    LAS unsigned char* vb = lds + wv * VBYTES;
    const int q4 = (lane & 15) >> 2, p4 = lane & 3, cg16 = (lane >> 4) & 1;
    LAS const unsigned char* vad = vb + (4 * hi + q4) * VP + (16 * cg16) * 2 + 8 * p4;
    const unsigned klo = (unsigned)(r32 * kpitch + 8 * hi) * 2u, rlo = (unsigned)(r32 * 32 + 8 * hi) * 2u, vlo = (unsigned)((lane / VCH) * vpitch + (lane % VCH) * 8) * 2u;
    float m = -1e30f, l = 0.f;
#pragma unroll
    for (int b = 0; b < NB; ++b)
#pragma unroll
        for (int r = 0; r < 16; ++r) O[b][r] = 0.f;
    constexpr bool PFV = DV <= 64;
    bf16x8 kfN[DK / 16]; u32x4 vrN[NVL];
#define SP_LOAD(t) do { const char* kbt_ = (const char*)Kg + (size_t)(t) * 64 * kpitch; \
        _Pragma("unroll") for (int s_ = 0; s_ < (MLA ? 4 : DK / 16); ++s_) kfN[s_] = *(const bf16x8*)(kbt_ + klo + 32 * s_); \
        if (MLA) { const char* rr_ = (const char*)KRg + (size_t)(t) * 2048; kfN[DK / 16 - 2] = *(const bf16x8*)(rr_ + rlo); kfN[DK / 16 - 1] = *(const bf16x8*)(rr_ + rlo + 32); } \
        const char* vbt_ = (const char*)Vg + (size_t)(t) * 64 * vpitch; \
        if (PFV) { _Pragma("unroll") for (int i_ = 0; i_ < NVL; ++i_) vrN[i_] = *(const u32x4*)(vbt_ + (size_t)i_ * (64 / VCH) * vpitch * 2 + vlo); } } while (0)
    SP_LOAD(wv);
    for (int t = wv; t < 65; t += 8) {
        bf16x8 kf[DK / 16];
#pragma unroll
        for (int s = 0; s < DK / 16; ++s) kf[s] = kfN[s];
        if (PFV) {
#pragma unroll
            for (int i = 0; i < NVL; ++i) *(LAS u32x4*)(vb + ((lane / VCH) + i * (64 / VCH)) * VP + (lane % VCH) * 16) = vrN[i];
            if (t + 8 < 65) SP_LOAD(t + 8);
        } else {
            if (t + 8 < 65) SP_LOAD(t + 8);
            const char* vbt = (const char*)Vg + (size_t)t * 64 * vpitch;
#pragma unroll
            for (int i0 = 0; i0 < NVL; i0 += 4) {
                u32x4 vr[4];
#pragma unroll
                for (int i = 0; i < 4; ++i) vr[i] = *(const u32x4*)(vbt + (size_t)(i0 + i) * (64 / VCH) * vpitch * 2 + vlo);
#pragma unroll
                for (int i = 0; i < 4; ++i) *(LAS u32x4*)(vb + ((lane / VCH) + (i0 + i) * (64 / VCH)) * VP + (lane % VCH) * 16) = vr[i];
            }
        }
        f32x16 p0;
#pragma unroll
        for (int r = 0; r < 16; ++r) p0[r] = 0.f;
#pragma unroll
        for (int s = 0; s < DK / 16; ++s) p0 = MFMA32(kf[s], qf[s], p0);
#pragma unroll
        for (int r = 0; r < 16; ++r) { float x = p0[r] * scale_l2e; if (ALIBI) x -= slope_l2e * fabsf((float)(qpos - (32 * t + crow(r, hi)))); p0[r] = x; }
        float mx = max2f(p0[0], p0[1]);
#pragma unroll
        for (int r = 2; r < 16; r += 2) mx = max3f(mx, p0[r], p0[r + 1]);
        mx = max2f(mx, shfl32(mx));
        const float mnew = max2f(m, mx), alpha = __builtin_amdgcn_exp2f(m - mnew); m = mnew;
        float rs = 0.f;
#pragma unroll
        for (int r = 0; r < 16; ++r) { p0[r] = __builtin_amdgcn_exp2f(p0[r] - mnew); rs += p0[r]; }
        l = l * alpha + rs;
#pragma unroll
        for (int b = 0; b < NB; ++b)
#pragma unroll
            for (int r = 0; r < 16; ++r) O[b][r] *= alpha;
#pragma unroll
        for (int s = 0; s < 2; ++s) {
            const bf16x8 pb = pack8(p0, 8 * s);
#pragma unroll
            for (int b = 0; b < NB; ++b) {
                const s16x4 lo = __builtin_amdgcn_ds_read_tr16_b64_v4i16((LAS s16x4*)(vad + 16 * s * VP + 64 * b));
                const s16x4 hi4 = __builtin_amdgcn_ds_read_tr16_b64_v4i16((LAS s16x4*)(vad + (16 * s + 8) * VP + 64 * b));
                O[b] = MFMA32(__builtin_shufflevector(lo, hi4, 0, 1, 2, 3, 4, 5, 6, 7), pb, O[b]);
            }
        }
        asm volatile("s_waitcnt lgkmcnt(0)" ::: "memory");
    }
#undef SP_LOAD
    __syncthreads();
    if (wv > 0) {
        LAS float* d = (LAS float*)(lds + (wv - 1) * DUMP) + lane;
#pragma unroll
        for (int b = 0; b < NB; ++b)
#pragma unroll
            for (int r = 0; r < 16; ++r) d[(b * 16 + r) * 64] = O[b][r];
        d[NB * 16 * 64] = m; d[(NB * 16 + 1) * 64] = l;
    }
    __syncthreads();
    if (wv == 0) {
#pragma unroll 1
        for (int w2 = 0; w2 < 7; ++w2) {
            LAS const float* d = (LAS const float*)(lds + w2 * DUMP) + lane;
            const float m2 = d[NB * 16 * 64], l2 = d[(NB * 16 + 1) * 64];
            const float mnew = fmaxf(m, m2), a = __builtin_amdgcn_exp2f(m - mnew), a2 = __builtin_amdgcn_exp2f(m2 - mnew); m = mnew;
            l = l * a + l2 * a2;
#pragma unroll
            for (int b = 0; b < NB; ++b)
#pragma unroll
                for (int r = 0; r < 16; ++r) O[b][r] = O[b][r] * a + d[(b * 16 + r) * 64] * a2;
        }
    }
    __syncthreads();
    lsum = l;
}

struct AttnCtx {
    const bf16_t *qa, *proj, *kvp, *kvs, *krbp, *krbs, *dks, *dvs; bf16_t* mix; const float* rope; const float* g_subln; float lam; float* park;
};
template <bool samp>
__device__ __forceinline__ void diff_unit(LAS unsigned char* lds, const AttnCtx& C, int h, int w, int nt_unit, int nt_wave, int nvalid_last, bool wvalid, int qi0, unsigned qrow0, size_t krow0) {
    const int lane = lane_id(), r32 = lane & 31, hi = lane >> 5;
    const unsigned qrow = qrow0 + r32; const int qpos = (samp ? 2048 : qi0) + r32;
        const float slope = h == 0 ? 0.25f : h == 1 ? 0.0625f : h == 2 ? 0.015625f : 0.00390625f;
        const bf16_t* Kb = samp ? C.dks + krow0 * 512 + h * 128 : C.proj + krow0 * NIN + 1024 + h * 128; const int kpitch = samp ? 512 : NIN;
        const bf16_t* Vb = samp ? C.dvs + krow0 * 512 + h * 128 : C.proj + krow0 * NIN + 1536 + h * 128;
        f32x16 O1[4], O2[4]; float l1, l2;
        {
            bf16x8 qf[4]; const bf16_t* qp = C.proj + (size_t)qrow * NIN + 512 + h * 128 + 8 * hi;
#pragma unroll
            for (int s = 0; s < 4; ++s) qf[s] = *(const bf16x8*)(qp + 16 * s);
            if (samp) sample_pass<64, 128, false, true>(lds, qf, Kb, kpitch, nullptr, Vb, kpitch, 0.125f * L2E, slope * L2E, qpos, O1, l1, w);
            else flash_pass<64, 128, false, true, true>(lds, qf, Kb, kpitch, nullptr, Vb, kpitch, nt_unit, nt_wave, nvalid_last, 0.125f * L2E, slope * L2E, qpos, 0, O1, l1, w);
        }
        {
            f32x4* park = (f32x4*)(C.park + ((size_t)(blockIdx.x * NWAVES + w) * 64 + lane_id()) * 64);
            l1 += shfl32(l1); const float i1 = 1.f / l1;
#pragma unroll
            for (int bk = 0; bk < 4; ++bk)
#pragma unroll
                for (int g = 0; g < 4; ++g) park[bk * 4 + g] = (f32x4){O1[bk][4 * g] * i1, O1[bk][4 * g + 1] * i1, O1[bk][4 * g + 2] * i1, O1[bk][4 * g + 3] * i1};
        }
        {
            const int ln = lane_id();
            bf16x8 qf[4]; const bf16_t* qp = C.proj + (size_t)(qrow0 + (ln & 31)) * NIN + 512 + h * 128 + 64 + 8 * (ln >> 5);
#pragma unroll
            for (int s = 0; s < 4; ++s) qf[s] = *(const bf16x8*)(qp + 16 * s);
            if (samp) sample_pass<64, 128, false, true>(lds, qf, Kb + 64, kpitch, nullptr, Vb, kpitch, 0.125f * L2E, slope * L2E, 2048 + (ln & 31), O2, l2, w);
            else flash_pass<64, 128, false, true, true>(lds, qf, Kb + 64, kpitch, nullptr, Vb, kpitch, nt_unit, nt_wave, nvalid_last, 0.125f * L2E, slope * L2E, qi0 + (ln & 31), 0, O2, l2, w);
        }
        l2 += shfl32(l2);
        const float i2 = C.lam / l2;
        const f32x4* park = (const f32x4*)(C.park + ((size_t)(blockIdx.x * NWAVES + w) * 64 + lane_id()) * 64);
        float ss = 0.f;
#pragma unroll
        for (int bk = 0; bk < 4; ++bk)
#pragma unroll
            for (int g = 0; g < 4; ++g) { const f32x4 pv = park[bk * 4 + g];
#pragma unroll
                for (int e = 0; e < 4; ++e) { const float o = pv[e] - O2[bk][4 * g + e] * i2; O1[bk][4 * g + e] = o; ss += o * o; } }
        ss += shfl32(ss);
        const float rn = 0.8f / sqrtf(ss * (1.f / 128.f) + EPS);
        if (wvalid) {
            const int ln = lane_id(), hi2 = ln >> 5;
            bf16_t* op = C.mix + (size_t)(qrow0 + (ln & 31)) * 1024 + 512 + h * 128 + 4 * hi2;
#pragma unroll
            for (int bk = 0; bk < 4; ++bk)
#pragma unroll
                for (int g = 0; g < 4; ++g) { const f32x4 gs = *(const f32x4*)(C.g_subln + 32 * bk + 8 * g + 4 * hi2);
                    u32x2 o; o.x = pk2(O1[bk][4 * g] * rn * gs[0], O1[bk][4 * g + 1] * rn * gs[1]); o.y = pk2(O1[bk][4 * g + 2] * rn * gs[2], O1[bk][4 * g + 3] * rn * gs[3]);
                    *(u32x2*)(op + 32 * bk + 8 * g) = o; }
        }
}
constexpr int ATT_UNITS = 384 + 8 * 384;
__device__ __forceinline__ void attn_unit(LAS unsigned char* lds, const AttnCtx& C, int idx, int w) {
    const int lane = lane_id(), r32 = lane & 31, hi = lane >> 5;
    int kind, b, h, qb;
    if (idx < 128) { kind = 3; b = idx >> 2; h = idx & 3; qb = 0; }
    else if (idx < 384) { kind = 2; const int j = idx - 128; b = j >> 3; h = j & 7; qb = 0; }
    else { const int j = idx - 384; qb = 7 - j / 384; const int r = j % 384; if (r < 128) { kind = 1; b = r >> 2; h = r & 3; } else { kind = 0; b = (r - 128) >> 3; h = (r - 128) & 7; } }
    const bool samp = kind >= 2;
    const int nt_unit = samp ? 33 : 4 * qb + 4;
    const int nt_wave = samp ? (w == 0 ? 33 : 0) : 4 * qb + (w >> 1) + 1;
    const int nvalid_last = samp ? 32 : 64;
    const bool wvalid = samp ? (w == 0) : true;
    const int qi0 = samp ? 0 : 256 * qb + 32 * w;
    const unsigned qrow0 = samp ? (unsigned)(TP + b * 32) : (unsigned)(b * 2048 + qi0);
    const unsigned qrow = qrow0 + r32;
    const int qpos = (samp ? 2048 : qi0) + r32;
    const size_t krow0 = samp ? (size_t)b * SK : (size_t)b * 2048;
    if (kind == 0 || kind == 2) {
        bf16x8 qf[6];
        const bf16_t* qp = C.qa + (size_t)qrow * 768 + h * 96 + 8 * hi;
#pragma unroll
        for (int s = 0; s < 6; ++s) qf[s] = *(const bf16x8*)(qp + 16 * s);
        {
            const float* tb = C.rope + (size_t)qpos * 32 + 8 * hi;
            const f32x4 c0 = *(const f32x4*)tb, c1 = *(const f32x4*)(tb + 4), s0 = *(const f32x4*)(tb + 16), s1 = *(const f32x4*)(tb + 20);
            const u32x4 a = __builtin_bit_cast(u32x4, qf[4]), bq = __builtin_bit_cast(u32x4, qf[5]); u32x4 oa, ob;
#pragma unroll
            for (int j = 0; j < 4; ++j) {
                const float x1l = bflo(a[j]), x1h = bfhi(a[j]), x2l = bflo(bq[j]), x2h = bfhi(bq[j]);
                const float cl = j < 2 ? c0[2 * j] : c1[2 * j - 4], ch = j < 2 ? c0[2 * j + 1] : c1[2 * j - 3], sl = j < 2 ? s0[2 * j] : s1[2 * j - 4], sh = j < 2 ? s0[2 * j + 1] : s1[2 * j - 3];
                oa[j] = pk2(x1l * cl - x2l * sl, x1h * ch - x2h * sh); ob[j] = pk2(x1l * sl + x2l * cl, x1h * sh + x2h * ch);
            }
            qf[4] = __builtin_bit_cast(bf16x8, oa); qf[5] = __builtin_bit_cast(bf16x8, ob);
        }
        const bf16_t* kv = samp ? C.kvs : C.kvp; const bf16_t* kr = samp ? C.krbs : C.krbp;
        f32x16 O[2]; float l;
        if (samp) sample_pass<96, 64, true, false>(lds, qf, kv + krow0 * 1024 + h * 64, 1024, kr + krow0 * 32, kv + krow0 * 1024 + 512 + h * 64, 1024, 0.10206207261596577f * L2E, 0.f, qpos, O, l, w);
        else flash_pass<96, 64, true, false, false>(lds, qf, kv + krow0 * 1024 + h * 64, 1024, kr + krow0 * 32, kv + krow0 * 1024 + 512 + h * 64, 1024,
                                        nt_unit, nt_wave, nvalid_last, 0.10206207261596577f * L2E, 0.f, qpos, 0, O, l, w);
        l += shfl32(l);
        const float il = 1.f / l;
        if (wvalid) {
            const int ln = lane_id();
            bf16_t* op = C.mix + (size_t)(qrow0 + (ln & 31)) * 1024 + h * 64 + 4 * (ln >> 5);
#pragma unroll
            for (int bk = 0; bk < 2; ++bk)
#pragma unroll
                for (int g = 0; g < 4; ++g) { u32x2 o; o.x = pk2(O[bk][4 * g] * il, O[bk][4 * g + 1] * il); o.y = pk2(O[bk][4 * g + 2] * il, O[bk][4 * g + 3] * il);
                    *(u32x2*)(op + 32 * bk + 8 * g) = o; }
        }
    } else {
        if (samp) diff_unit<true>(lds, C, h, w, nt_unit, nt_wave, nvalid_last, wvalid, qi0, qrow0, krow0);
        else diff_unit<false>(lds, C, h, w, nt_unit, nt_wave, nvalid_last, wvalid, qi0, qrow0, krow0);
    }
}

#define XB_TMO      128
#define XB_XCNT(j)  (256  + 64 * (j))
#define XB_XSUB(j)  (1280 + 64 * (j))
#define XB_XGEN(j)  (2304 + 64 * (j))
#define XB_TOP      3328
#define XB_TOPGEN   3392
#define XCD_BAR_WORDS 3456
#define XB_SPIN_CAP (1u << 18)
__device__ __forceinline__ unsigned xb_ld(unsigned* p)              { return __hip_atomic_load(p, __ATOMIC_RELAXED, __HIP_MEMORY_SCOPE_AGENT); }
__device__ __forceinline__ unsigned xb_add(unsigned* p, unsigned v) { return __hip_atomic_fetch_add(p, v, __ATOMIC_RELAXED, __HIP_MEMORY_SCOPE_AGENT); }
__device__ __forceinline__ unsigned xb_xcc_id() { return (unsigned)__builtin_amdgcn_s_getreg((3 << 11) | 20) & 0xFu; }
#define XB_SPIN(cond, bar) do { unsigned _sp = 0; while (cond) { __builtin_amdgcn_s_sleep(1); \
    if ((++_sp & 255u) == 0u) { if (xb_ld(&(bar)[XB_TMO])) break; if (_sp > XB_SPIN_CAP) { atomicAdd(&(bar)[XB_TMO], 1u); break; } } } } while (0)
__device__ __forceinline__ void xcd_barrier_complete(unsigned* bar, unsigned x, unsigned G, unsigned& nloc, unsigned& nx) {
    unsigned sum, cnt, mine, sp = 0u;
    for (;;) {
        sum = 0u; cnt = 0u; mine = 0u;
#pragma unroll
        for (unsigned j = 0; j < 16; ++j) { const unsigned c = xb_ld(&bar[XB_XCNT(j)]); sum += c; cnt += (c > 0u) ? 1u : 0u; mine = (j == x) ? c : mine; }
        if (sum == G) break;
        __builtin_amdgcn_s_sleep(1);
        if ((++sp & 255u) == 0u) { if (xb_ld(&bar[XB_TMO])) break; if (sp > XB_SPIN_CAP) { atomicAdd(&bar[XB_TMO], 1u); break; } }
    }
    nloc = mine > 0u ? mine : 1u; nx = cnt > 0u ? cnt : 1u;
}
__device__ __forceinline__ void xcd_barrier(unsigned* bar, volatile LAS unsigned* st, unsigned G, int wave) {
    asm volatile("s_waitcnt vmcnt(0) lgkmcnt(0)" ::: "memory");
    __syncthreads();
    if (wave == 0 && lane_id() == 0) {
        const unsigned x = xb_xcc_id();
        __builtin_amdgcn_s_waitcnt(0);
        unsigned nloc = st[0], nx = st[1];
        if (nloc == 0u) { xcd_barrier_complete(bar, x, G, nloc, nx); st[0] = nloc; st[1] = nx; }
        const unsigned old = xb_add(&bar[XB_XSUB(x)], 1u);
        const unsigned gen = old / nloc;
        if (old + 1u == (gen + 1u) * nloc) {
            __builtin_amdgcn_fence(__ATOMIC_RELEASE, "agent");
            asm volatile("s_waitcnt vmcnt(0)" ::: "memory");
            const unsigned og = xb_add(&bar[XB_TOP], 1u);
            const unsigned tg = og / nx;
            if (og + 1u == (tg + 1u) * nx) xb_add(&bar[XB_TOPGEN], 1u);
            else XB_SPIN(xb_ld(&bar[XB_TOPGEN]) == tg, bar);
            __builtin_amdgcn_fence(__ATOMIC_ACQUIRE, "agent");
            xb_add(&bar[XB_XGEN(x)], 1u);
            asm volatile("s_waitcnt vmcnt(0)" ::: "memory");
        } else {
            XB_SPIN(xb_ld(&bar[XB_XGEN(x)]) == gen, bar);
            __builtin_amdgcn_fence(__ATOMIC_ACQUIRE, "agent");
            asm volatile("s_waitcnt vmcnt(0)" ::: "memory");
        }
    }
    __syncthreads();
}
struct Args { const float* in[32]; float* out; unsigned char* ws; int ph_lo, ph_hi; };
constexpr size_t O_YP = 0, O_YS = O_YP + (size_t)TP * DM, O_CKVP = O_YS + (size_t)TS * DM, O_KRP = O_CKVP + (size_t)TP * 256, O_DKP = O_KRP + (size_t)TP * 32, O_DVP = O_DKP + (size_t)TP * 512,
                 O_CONVP = O_DVP + (size_t)TP * 512, O_CKVS = O_CONVP + (size_t)32 * 2 * DFF2, O_KRS = O_CKVS + (size_t)TS * 256, O_DKS = O_KRS + (size_t)TS * 32, O_DVS = O_DKS + (size_t)TS * 512,
                 O_CONVS = O_DVS + (size_t)TS * 512, O_END = O_CONVS + (size_t)32 * 2 * DFF2;

__device__ __forceinline__ void transpose_item(const float* W, int N, int k0, int nsrc0, bf16_t* WT, int K, int ndst0, LAS float* scr, int lane) {
    const int c = lane & 7;
    if (nsrc0 < 0) {
#pragma unroll
        for (int j = 0; j < 4; ++j) { const int n = (lane >> 3) + 8 * j; *(u32x4*)(WT + (size_t)(ndst0 + n) * K + k0 + 8 * c) = (u32x4){0u, 0u, 0u, 0u}; }
        return;
    }
#pragma unroll 8
    for (int i = 0; i < 32; ++i) { const int kk = 2 * i + (lane >> 5); scr[kk * 33 + (lane & 31)] = W[(size_t)(k0 + kk) * N + nsrc0 + (lane & 31)]; }
    LDS_WAIT();
#pragma unroll
    for (int j = 0; j < 4; ++j) { const int n = (lane >> 3) + 8 * j; const LAS float* s = scr + (8 * c) * 33 + n;
        u32x4 o; o.x = pk2(s[0 * 33], s[1 * 33]); o.y = pk2(s[2 * 33], s[3 * 33]); o.z = pk2(s[4 * 33], s[5 * 33]); o.w = pk2(s[6 * 33], s[7 * 33]);
        *(u32x4*)(WT + (size_t)(ndst0 + n) * K + k0 + 8 * c) = o; }
    LDS_WAIT();
}
__device__ __forceinline__ void sincos_d(double a, float& c, float& s) {
    const double TWO_PI = 6.283185307179586476925286766559;
    const double k = __builtin_rint(a / TWO_PI); const double r = a - k * TWO_PI; const double r2 = r * r;
    double sn = 1.0, cs = 1.0;
#pragma unroll
    for (int i = 14; i >= 1; --i) { sn = 1.0 - sn * r2 / (double)((2 * i) * (2 * i + 1)); cs = 1.0 - cs * r2 / (double)((2 * i - 1) * (2 * i)); }
    c = (float)cs; s = (float)(sn * r);
}
__device__ __forceinline__ void ln_row2(const float* hrow, bf16_t* brow, const float* g, const float* bta, float* stat, int lane) {
    f32x4 v[2][4]; float s[2] = {0.f, 0.f};
#pragma unroll
    for (int r = 0; r < 2; ++r)
#pragma unroll
        for (int j = 0; j < 4; ++j) v[r][j] = *((const f32x4*)(hrow + (size_t)r * DM) + lane + 64 * j);
#pragma unroll
    for (int r = 0; r < 2; ++r)
#pragma unroll
        for (int j = 0; j < 4; ++j) s[r] += (v[r][j].x + v[r][j].y) + (v[r][j].z + v[r][j].w);
    float mean[2], rstd[2];
#pragma unroll
    for (int r = 0; r < 2; ++r) { mean[r] = wave_sum(s[r]) * (1.f / 1024.f); float s2 = 0.f;
#pragma unroll
        for (int j = 0; j < 4; ++j) { v[r][j] = v[r][j] - mean[r]; s2 += (v[r][j].x * v[r][j].x + v[r][j].y * v[r][j].y) + (v[r][j].z * v[r][j].z + v[r][j].w * v[r][j].w); }
        rstd[r] = 1.f / sqrtf(wave_sum(s2) * (1.f / 1024.f) + EPS); }
    if (lane == 0) { *(f32x2*)stat = (f32x2){mean[0], rstd[0]}; *(f32x2*)(stat + 2) = (f32x2){mean[1], rstd[1]}; }
#pragma unroll
    for (int j = 0; j < 4; ++j) { const f32x4 gg = *((const f32x4*)g + lane + 64 * j), bb = *((const f32x4*)bta + lane + 64 * j);
#pragma unroll
        for (int r = 0; r < 2; ++r) { const f32x4 y = v[r][j] * rstd[r] * gg + bb; u32x2 o; o.x = pk2(y.x, y.y); o.y = pk2(y.z, y.w); *((u32x2*)(brow + (size_t)r * DM) + lane + 64 * j) = o; } }
}

__global__ void __launch_bounds__(NTHR, 2) fwd_kernel(Args args) {
    extern __shared__ __attribute__((aligned(16))) unsigned char lds_raw[];
    LAS unsigned char* lds = (LAS unsigned char*)lds_raw;
    cg::grid_group grid = cg::this_grid();
    const int wave = __builtin_amdgcn_readfirstlane((int)threadIdx.x >> 6);
    const int G = gridDim.x, bx = blockIdx.x;
    const int gw = bx * NWAVES + wave, NGW = G * NWAVES;
    const size_t NGT = (size_t)G * NTHR;
#define PHASE_IDS() const int lane = lane_id(); const int tid = wave * 64 + lane; const size_t gt = (size_t)bx * NTHR + tid; (void)tid; (void)gt
    unsigned char* ws = args.ws;
    float* out = args.out;
    const float* const* in = args.in;
    unsigned* ctl = (unsigned*)(ws + WS_CTL);
    float* rope = (float*)(ws + WS_ROPE);
    float* ctab = (float*)(ws + WS_CTAB);
    float* uspec = (float*)(ws + WS_USPEC);
    float* stat1 = (float*)(ws + WS_PARK); float* stat2 = stat1 + 2 * (size_t)T;
    bf16_t *win_t = (bf16_t*)(ws + WS_WIN), *wuq_t = (bf16_t*)(ws + WS_WUQ), *wukv_t = (bf16_t*)(ws + WS_WUKV), *wo_t = (bf16_t*)(ws + WS_WO), *wup_t = (bf16_t*)(ws + WS_WUP),
           *wdn_t = (bf16_t*)(ws + WS_WDN), *wg_t = (bf16_t*)(ws + WS_WG), *wpp_t = (bf16_t*)(ws + WS_WPP);
    bf16_t *pb = (bf16_t*)(ws + WS_PB), *proj = (bf16_t*)(ws + WS_PROJ), *xb = (bf16_t*)(ws + WS_XB), *cqb = (bf16_t*)(ws + WS_CQB), *callp = (bf16_t*)(ws + WS_CALLP), *calls = (bf16_t*)(ws + WS_CALLS);
    bf16_t *mix = (bf16_t*)(ws + WS_MIX), *pp = (bf16_t*)(ws + WS_PP), *dks = (bf16_t*)(ws + WS_DKS), *dvs = (bf16_t*)(ws + WS_DVS), *qa = (bf16_t*)(ws + WS_QA), *kvp = (bf16_t*)(ws + WS_KVP), *kvs = (bf16_t*)(ws + WS_KVS);
    bf16_t *krbp = (bf16_t*)(ws + WS_KRBP), *krbs = (bf16_t*)(ws + WS_KRBS), *h1b = (bf16_t*)(ws + WS_H1B) + 2 * DM, *act = (bf16_t*)(ws + WS_ACT), *h2b = (bf16_t*)(ws + WS_H2B);
    float* hbuf = (float*)(ws + WS_H);
    const int lo = args.ph_lo, hi_ph = args.ph_hi;
#define IN(k) (lo <= (k) && (k) < hi_ph)
#define SEAM(k) do { if (IN(k) && IN((k) + 1)) xcd_barrier(xbar, xst, (unsigned)G, wave); } while (0)
    unsigned* xbar = ctl + 256;
    volatile LAS unsigned* xst = (volatile LAS unsigned*)(lds + LDS_BYTES - 16);
    if (wave == 0 && lane_id() == 0) { xst[0] = 0u; xst[1] = 0u; (void)xb_add(&xbar[XB_XCNT(xb_xcc_id())], 1u); }
    __syncthreads();
    if (lo < -1000) grid.sync();

    if (IN(0)) {
        PHASE_IDS();
        if (bx == 0 && tid == 0) {
            float s1 = 0.f, s2 = 0.f;
            for (int i = 0; i < 64; ++i) { s1 += in[15][i] * in[16][i]; s2 += in[17][i] * in[18][i]; }
            ((float*)ctl)[1] = __expf(s1) - __expf(s2) + 0.2f;
            ctl[0] = 0u; ctl[2] = 0u; ctl[4] = 0u;
        }
        LAS float* scr = (LAS float*)(lds + wave * 16384);
        constexpr int I_IN = 16 * 72, I_UQ = 4 * 24, I_UKV = 4 * 32, I_O = 16 * 32, I_UP = 16 * 176, I_DN = 44 * 32, I_G = 16 * 32, I_PP = 4 * 32;
        constexpr int NITEMS = I_IN + I_UQ + I_UKV + I_O + I_UP + I_DN + I_G + I_PP;
        for (int it = gw; it < NITEMS; it += NGW) {
            int r = it;
            if (r < I_IN) { const int kb = r / 72, nb = r % 72, nd = nb * 32; int ns;
                if (nd < 512) ns = nd; else if (nd < 2048) ns = nd + 32; else if (nd < 2080) ns = nd - 2048 + 512; else ns = -1;
                transpose_item(in[9], 2080, kb * 64, ns, win_t, 1024, nd, scr, lane); continue; } r -= I_IN;
            if (r < I_UQ) { transpose_item(in[11], 768, (r / 24) * 64, (r % 24) * 32, wuq_t, 256, (r % 24) * 32, scr, lane); continue; } r -= I_UQ;
            if (r < I_UKV) { const int kb = r / 32, nb = r % 32; if (nb < 16) transpose_item(in[13], 512, kb * 64, nb * 32, wukv_t, 256, nb * 32, scr, lane);
                else transpose_item(in[14], 512, kb * 64, (nb - 16) * 32, wukv_t, 256, nb * 32, scr, lane); continue; } r -= I_UKV;
            if (r < I_O) { transpose_item(in[20], 1024, (r / 32) * 64, (r % 32) * 32, wo_t, 1024, (r % 32) * 32, scr, lane); continue; } r -= I_O;
            if (r < I_UP) { const int kb = r / 176, nb = r % 176, nd = nb * 32;
                const int pn = nd >> 8, bj = (nd >> 7) & 1, c = nd & 127; transpose_item(in[23], DFF2, kb * 64, bj * DFF + 128 * pn + c, wup_t, 1024, nd, scr, lane); continue; } r -= I_UP;
            if (r < I_DN) { transpose_item(in[26], 1024, (r / 32) * 64, (r % 32) * 32, wdn_t, DFF, (r % 32) * 32, scr, lane); continue; } r -= I_DN;
            if (r < I_G) { transpose_item(in[29], 1024, (r / 32) * 64, (r % 32) * 32, wg_t, 1024, (r % 32) * 32, scr, lane); continue; } r -= I_G;
            transpose_item(in[31], 1024, (r / 32) * 64, (r % 32) * 32, wpp_t, 256, (r % 32) * 32, scr, lane);
        }
        {
#define CVT_PASS(N_, SH_, MSK_, W_, SRCP_, SRCS_, DST_) do { size_t i0 = gt; \
            for (; i0 + 3 * NGT < (N_); i0 += 4 * NGT) { f32x4 a_[4], b_[4]; \
                _Pragma("unroll") for (int j = 0; j < 4; ++j) { const size_t i = i0 + (size_t)j * NGT; const size_t row = i >> (SH_); const int c8 = (int)(i & (MSK_)); \
                    const float* src = row < TP ? (SRCP_) + row * (W_) : (SRCS_) + (row - TP) * (W_); a_[j] = *(const f32x4*)(src + c8 * 8); b_[j] = *(const f32x4*)(src + c8 * 8 + 4); } \
                _Pragma("unroll") for (int j = 0; j < 4; ++j) { const size_t i = i0 + (size_t)j * NGT; const size_t row = i >> (SH_); const int c8 = (int)(i & (MSK_)); \
                    u32x4 o; o.x = pk2(a_[j].x, a_[j].y); o.y = pk2(a_[j].z, a_[j].w); o.z = pk2(b_[j].x, b_[j].y); o.w = pk2(b_[j].z, b_[j].w); *(u32x4*)((DST_) + row * (W_) + c8 * 8) = o; } } \
            for (; i0 < (N_); i0 += NGT) { const size_t row = i0 >> (SH_); const int c8 = (int)(i0 & (MSK_)); \
                const float* src = row < TP ? (SRCP_) + row * (W_) : (SRCS_) + (row - TP) * (W_); const f32x4 a_ = *(const f32x4*)(src + c8 * 8), b_ = *(const f32x4*)(src + c8 * 8 + 4); \
                u32x4 o; o.x = pk2(a_.x, a_.y); o.y = pk2(a_.z, a_.w); o.z = pk2(b_.x, b_.y); o.w = pk2(b_.z, b_.w); *(u32x4*)((DST_) + row * (W_) + c8 * 8) = o; } } while (0)
            CVT_PASS((size_t)T * 128, 7, 127, DM, in[0], in[1], xb);
            CVT_PASS((size_t)T * 32, 5, 31, 256, in[7], in[8], pb);
#undef CVT_PASS
        }
        for (size_t i = gt; i < (size_t)DFF; i += NGT) { const float* cw = in[24]; const float* cb = in[25];
            float* t = ctab + (i >> 2) * 32 + (i & 3); t[0] = cw[i]; t[4] = cw[DFF2 + i]; t[8] = cw[2 * DFF2 + i]; t[12] = cb[i];
            t[16] = cw[DFF + i]; t[20] = cw[DFF2 + DFF + i]; t[24] = cw[2 * DFF2 + DFF + i]; t[28] = cb[DFF + i]; }
        for (size_t i = gt; i < (size_t)SK * 16; i += NGT) { const int pos = (int)(i >> 4), k = (int)(i & 15); const float ang = (float)pos * ROPE_INV[k];
            float c, s; sincos_d((double)ang, c, s); rope[pos * 32 + k] = c; rope[pos * 32 + 16 + k] = s; }
    }
    SEAM(0);
    if (IN(1)) {
        pg8::Gemm g{xb, win_t, DM, DM}; pg8::StaticOrder S; S.init(T / 256, NIN / 256, G, bx); pg8::EpiProj E{proj, out + O_DKP, out + O_DKS, out + O_DVP, out + O_DVS};
        pg8::gemm_phase<pg8::EpiProj, 0>(lds, g, S, E, wave);
    }
    SEAM(1);
    if (IN(2)) {
        PHASE_IDS();
        for (int rb = gw * 4; rb < T; rb += NGW * 4) {
            u32x2 wq[4], wc[4]; unsigned short xa[4], xb2[4];
#pragma unroll
            for (int j = 0; j < 4; ++j) { const bf16_t* pr = proj + (size_t)(rb + j) * NIN; wq[j] = *(const u32x2*)(pr + 4 * lane); wc[j] = *(const u32x2*)(pr + 256 + 4 * lane);
                xa[j] = pr[2048 + (lane & 15)]; xb2[j] = pr[2064 + (lane & 15)]; }
            const f32x4 gq = *(const f32x4*)(in[10] + 4 * lane), gk = *(const f32x4*)(in[12] + 4 * lane);
#pragma unroll
            for (int j = 0; j < 4; ++j) {
                const int row = rb + j;
                const bool samp = row >= TP; const int sr = row - TP, sbb = sr >> 5, si = sr & 31;
                const size_t crw = samp ? (size_t)sbb * SK + 2048 + si : (size_t)row;
                const int pos = samp ? 2048 + si : (row & 2047);
                {
                    const u32x2 w = wq[j]; const float a0 = bflo(w.x), a1 = bfhi(w.x), a2 = bflo(w.y), a3 = bfhi(w.y);
                    const float r = 1.f / sqrtf(wave_sum(a0 * a0 + a1 * a1 + a2 * a2 + a3 * a3) * (1.f / 256.f) + EPS);
                    u32x2 o; o.x = pk2(a0 * r * gq.x, a1 * r * gq.y); o.y = pk2(a2 * r * gq.z, a3 * r * gq.w); *(u32x2*)(cqb + (size_t)row * 256 + 4 * lane) = o;
                }
                {
                    const u32x2 w = wc[j]; const float a0 = bflo(w.x), a1 = bfhi(w.x), a2 = bflo(w.y), a3 = bfhi(w.y);
                    const float r = 1.f / sqrtf(wave_sum(a0 * a0 + a1 * a1 + a2 * a2 + a3 * a3) * (1.f / 256.f) + EPS);
                    const f32x4 y = {a0 * r * gk.x, a1 * r * gk.y, a2 * r * gk.z, a3 * r * gk.w};
                    *(f32x4*)((samp ? out + O_CKVS + (size_t)sr * 256 : out + O_CKVP + (size_t)row * 256) + 4 * lane) = y;
                    u32x2 o; o.x = pk2(y.x, y.y); o.y = pk2(y.z, y.w); *(u32x2*)((samp ? calls + crw * 256 : callp + (size_t)row * 256) + 4 * lane) = o;
                }
                if (lane < 16) {
                    const float x1 = __uint_as_float((unsigned)xa[j] << 16), x2 = __uint_as_float((unsigned)xb2[j] << 16);
                    const float c = rope[pos * 32 + lane], sn = rope[pos * 32 + 16 + lane]; const float o1 = x1 * c - x2 * sn, o2 = x1 * sn + x2 * c;
                    float* ko = samp ? out + O_KRS + (size_t)sr * 32 : out + O_KRP + (size_t)row * 32; ko[lane] = o1; ko[16 + lane] = o2;
                    bf16_t* kb = samp ? krbs + crw * 32 : krbp + (size_t)row * 32; kb[lane] = (bf16_t)(pk2(o1, 0.f) & 0xffffu); kb[16 + lane] = (bf16_t)(pk2(o2, 0.f) & 0xffffu);
                }
                if (samp) { const bf16_t* pr = proj + (size_t)row * NIN; const u32x4 wk = *(const u32x4*)(pr + 1024 + 8 * lane), wv = *(const u32x4*)(pr + 1536 + 8 * lane);
                    *(u32x4*)(dks + crw * 512 + 8 * lane) = wk; *(u32x4*)(dvs + crw * 512 + 8 * lane) = wv; }
            }
        }
        for (int idx0 = gw; idx0 < 32 * PAST; idx0 += 2 * NGW) {
            f32x4 ac[2], k0[2], k1[2], v0[2], v1[2]; f32x2 ar[2];
#pragma unroll
            for (int j = 0; j < 2; ++j) { const int idx = idx0 + j * NGW; if (idx < 32 * PAST) {
                ac[j] = *(const f32x4*)(in[2] + (size_t)idx * 256 + 4 * lane); ar[j] = *(const f32x2*)(in[3] + (size_t)idx * 32 + 2 * (lane & 15));
                k0[j] = *(const f32x4*)(in[4] + (size_t)idx * 512 + 8 * lane); k1[j] = *(const f32x4*)(in[4] + (size_t)idx * 512 + 8 * lane + 4);
                v0[j] = *(const f32x4*)(in[5] + (size_t)idx * 512 + 8 * lane); v1[j] = *(const f32x4*)(in[5] + (size_t)idx * 512 + 8 * lane + 4); } }
#pragma unroll
            for (int j = 0; j < 2; ++j) { const int idx = idx0 + j * NGW; if (idx < 32 * PAST) {
                const int b = idx >> 11, sq = idx & 2047; const size_t crw = (size_t)b * SK + sq;
                { u32x2 o; o.x = pk2(ac[j].x, ac[j].y); o.y = pk2(ac[j].z, ac[j].w); *(u32x2*)(calls + crw * 256 + 4 * lane) = o; }
                if (lane < 16) *(unsigned*)(krbs + crw * 32 + 2 * lane) = pk2(ar[j].x, ar[j].y);
                { u32x4 o; o.x = pk2(k0[j].x, k0[j].y); o.y = pk2(k0[j].z, k0[j].w); o.z = pk2(k1[j].x, k1[j].y); o.w = pk2(k1[j].z, k1[j].w); *(u32x4*)(dks + crw * 512 + 8 * lane) = o; }
                { u32x4 o; o.x = pk2(v0[j].x, v0[j].y); o.y = pk2(v0[j].z, v0[j].w); o.z = pk2(v1[j].x, v1[j].y); o.w = pk2(v1[j].z, v1[j].w); *(u32x4*)(dvs + crw * 512 + 8 * lane) = o; } } }
        }
        for (int r = gw; r < 32; r += NGW) {
            const size_t crw = (size_t)32 * SK + r; const u32x4 z = {0u, 0u, 0u, 0u};
            *(u32x4*)(dks + crw * 512 + 8 * lane) = z; *(u32x4*)(dvs + crw * 512 + 8 * lane) = z; *(u32x4*)(kvs + crw * 1024 + 8 * lane) = z; *(u32x4*)(kvs + crw * 1024 + 512 + 8 * lane) = z;
            if (lane < 4) *(u32x4*)(krbs + crw * 32 + 8 * lane) = z;
        }
    }
    SEAM(2);
    if (IN(3)) {
        { pg8::Gemm g{cqb, wuq_t, 256, 256}; pg8::StaticOrder S; S.init(T / 256, 3, G, bx); pg8::EpiBf16 E{qa, 768}; pg8::gemm_phase<pg8::EpiBf16, 0>(lds, g, S, E, wave); }
        static_assert(WS_CALLS == WS_CALLP + (size_t)TP * 256 * 2 && WS_KVS == WS_KVP + (size_t)TP * 1024 * 2, "prompt and sample latent / K-V buffers must be contiguous for the merged GEMM");
        { pg8::Gemm g{callp, wukv_t, 256, 256}; pg8::StaticOrder S; S.init(TP / 256 + 32 * SK / 256, 4, G, bx); pg8::EpiBf16 E{kvp, 1024}; pg8::gemm_phase<pg8::EpiBf16, 0>(lds, g, S, E, wave); }
    }
    SEAM(3);
    if (IN(4)) {
        AttnCtx C{qa, proj, kvp, kvs, krbp, krbs, dks, dvs, mix, rope, in[19], __int_as_float(__builtin_amdgcn_readfirstlane(__float_as_int(((const float*)ctl)[1]))), (float*)(ws + WS_PARK)};
        LAS int* su = (LAS int*)lds;
        for (int rep = 0; rep < P4_REPEAT; ++rep)
        for (;;) {
            if (wave == 0) { const int ln = lane_id(); if (ln == 0) su[0] = (int)atomicAdd(ctl + 2 * rep + ln, 1u); }
            __syncthreads();
            const int idx = su[0];
            __syncthreads();
            if (idx >= ATT_UNITS) break;
            int wv = wave; asm volatile("" : "+s"(wv));
            attn_unit(lds + 256, C, idx, wv);
        }
    }
    SEAM(4);
    if (IN(5)) {
        pg8::Gemm g{mix, wo_t, DM, DM}; pg8::StaticOrder S; S.init(T / 256, 4, G, bx); pg8::EpiResX E{in[0], in[1], hbuf};
        pg8::gemm_phase<pg8::EpiResX, 0>(lds, g, S, E, wave);
    }
    SEAM(5);
    if (IN(6)) { PHASE_IDS(); for (int row = 2 * gw; row < T; row += 2 * NGW) ln_row2(hbuf + (size_t)row * DM, h1b + (size_t)row * DM, in[21], in[22], stat1 + 2 * (size_t)row, lane); }
    SEAM(6);
    if (IN(7)) {
        pg8::Gemm g{h1b - 2 * DM, wup_t, DM, DM}; pg8::StaticOrder S; S.init(265, 22, G, bx);
        pg8::EpiConvGlu E{act, ctab, uspec};
        for (int rep = 0; rep < P7_REPEAT; ++rep) pg8::gemm_phase<pg8::EpiConvGlu, 1>(lds, g, S, E, wave);
    }
    SEAM(7);
    if (IN(8)) {
        PHASE_IDS();
        for (size_t i = gt; i < (size_t)65 * (DFF / 2); i += NGT) {
            const int si = (int)(i / (DFF / 2)), j = 2 * (int)(i % (DFF / 2));
            const float* us = uspec + (size_t)si * 4 * DFF2;
            const int s = si <= 32 ? si * 2048 : TP + (si - 32) * 32;
            if (si >= 1) { float* o = (si <= 32 ? out + O_CONVP + (size_t)(si - 1) * 2 * DFF2 : out + O_CONVS + (size_t)(si - 33) * 2 * DFF2);
                *(f32x2*)(o + j) = *(const f32x2*)(us + j); *(f32x2*)(o + DFF + j) = *(const f32x2*)(us + DFF + j);
                *(f32x2*)(o + DFF2 + j) = *(const f32x2*)(us + DFF2 + j); *(f32x2*)(o + DFF2 + DFF + j) = *(const f32x2*)(us + DFF2 + DFF + j); }
            if (si < 64) {
                f32x2 sg0 = {0.f, 0.f}, sg1 = {0.f, 0.f}, sv0 = {0.f, 0.f}, sv1 = {0.f, 0.f};
                if (si >= 32) { const float* st = in[6] + (size_t)(si - 32) * 2 * DFF2; sg0 = *(const f32x2*)(st + j); sv0 = *(const f32x2*)(st + DFF + j); sg1 = *(const f32x2*)(st + DFF2 + j); sv1 = *(const f32x2*)(st + DFF2 + DFF + j); }
                const f32x2 ug0 = *(const f32x2*)(us + 2 * DFF2 + j), uv0 = *(const f32x2*)(us + 2 * DFF2 + DFF + j), ug1 = *(const f32x2*)(us + 3 * DFF2 + j), uv1 = *(const f32x2*)(us + 3 * DFF2 + DFF + j);
                f32x2 zg0, zv0, zg1, zv1;
#pragma unroll
                for (int e = 0; e < 2; ++e) { const float* tb = ctab + (size_t)((j + e) >> 2) * 32 + ((j + e) & 3);
                    zg0[e] = tb[12] + tb[0] * sg0[e] + tb[4] * sg1[e] + tb[8] * ug0[e]; zv0[e] = tb[28] + tb[16] * sv0[e] + tb[20] * sv1[e] + tb[24] * uv0[e];
                    zg1[e] = tb[12] + tb[0] * sg1[e] + tb[4] * ug0[e] + tb[8] * ug1[e]; zv1[e] = tb[28] + tb[16] * sv1[e] + tb[20] * uv0[e] + tb[24] * uv1[e]; }
                const f32x2 r0 = gelu_pk(zg0) * zv0, r1 = gelu_pk(zg1) * zv1;
                *(unsigned*)(act + (size_t)s * DFF + j) = pk2(r0.x, r0.y); *(unsigned*)(act + (size_t)(s + 1) * DFF + j) = pk2(r1.x, r1.y);
            }
        }
    }
    SEAM(8);
    if (IN(9)) {
        { pg8::Gemm g{act, wdn_t, DFF, DFF}; pg8::StaticOrder S; S.init(T / 256, 4, G, bx); pg8::EpiResH E{hbuf, stat1, in[21], in[22]}; pg8::gemm_phase<pg8::EpiResH, 0>(lds, g, S, E, wave); }
        if (bx >= 16) { pg8::Gemm g{pb, wpp_t, 256, 256}; pg8::StaticOrder S; S.init(T / 256, 4, G - 16, bx - 16); pg8::EpiBf16 E{pp, DM}; pg8::gemm_phase<pg8::EpiBf16, 0>(lds, g, S, E, wave); }
    }
    SEAM(9);
    if (IN(10)) { PHASE_IDS(); for (int row = 2 * gw; row < T; row += 2 * NGW) ln_row2(hbuf + (size_t)row * DM, h2b + (size_t)row * DM, in[27], in[28], stat2 + 2 * (size_t)row, lane); }
    SEAM(10);
    if (IN(11)) {
        pg8::Gemm g{h2b, wg_t, DM, DM}; pg8::StaticOrder S; S.init(T / 256, 4, G, bx); pg8::EpiGate E{hbuf, pp, in[30], out + O_YP, out + O_YS, stat2, in[27], in[28]};
        pg8::gemm_phase<pg8::EpiGate, 0>(lds, g, S, E, wave);
    }
#undef IN
#undef SEAM
}

extern "C" void kernel_launch(void* const* d_in, const int* in_sizes, int n_in, void* d_out, int out_size, void* d_ws, size_t ws_size, hipStream_t stream) {
    static int grid = 0;
    if (grid == 0) {
        if ((size_t)out_size != O_END) fprintf(stderr, "kernel_launch: note: out_size %d, expected %zu\n", out_size, (size_t)O_END);
        if (n_in != 32 || ws_size < WS_END) { fprintf(stderr, "kernel_launch: unexpected sizes: n_in %d out %d (want %zu) ws %zu (want %zu)\n", n_in, out_size, (size_t)O_END, ws_size, (size_t)WS_END); grid = -1; return; }
        int dev = 0, cus = 0, per_cu = 0;
        hipGetDevice(&dev); hipDeviceGetAttribute(&cus, hipDeviceAttributeMultiprocessorCount, dev);
        if (hipFuncSetAttribute((const void*)fwd_kernel, hipFuncAttributeMaxDynamicSharedMemorySize, LDS_BYTES) != hipSuccess) { fprintf(stderr, "kernel_launch: hipFuncSetAttribute failed\n"); grid = -1; return; }
        if (hipOccupancyMaxActiveBlocksPerMultiprocessor(&per_cu, (const void*)fwd_kernel, NTHR, LDS_BYTES) != hipSuccess || per_cu < 1) { fprintf(stderr, "kernel_launch: occupancy query says %d blocks/CU\n", per_cu); per_cu = 1; }
        (void)hipGetLastError();
        grid = cus;
    }
    if (grid < 0) return;
    Args a{};
    for (int i = 0; i < 32; ++i) a.in[i] = (const float*)d_in[i];
    a.out = (float*)d_out; a.ws = (unsigned char*)d_ws;
    (void)hipMemsetAsync((char*)d_ws + WS_CTL, 0, 16384, stream);
#if N_LAUNCH_MODE == 1
    a.ph_lo = 0; a.ph_hi = 12;
    { void* kargs[] = {&a}; hipError_t e = hipLaunchCooperativeKernel((const void*)fwd_kernel, dim3(grid), dim3(NTHR), kargs, LDS_BYTES, stream);
      if (e != hipSuccess) fprintf(stderr, "kernel_launch: cooperative launch failed: %s (grid %d)\n", hipGetErrorString(e), grid); }
#else
    for (int p = 0; p < 12; ++p) { a.ph_lo = p; a.ph_hi = p + 1; void* kargs[] = {&a};
        hipError_t e = hipLaunchCooperativeKernel((const void*)fwd_kernel, dim3(grid), dim3(NTHR), kargs, LDS_BYTES, stream);
        if (e != hipSuccess) { fprintf(stderr, "kernel_launch: launch %d failed: %s\n", p, hipGetErrorString(e)); break; } }
#endif
}
```

```cpp
#include <hip/hip_runtime.h>
#include <hip/hip_cooperative_groups.h>
#include <cstdio>
#include <cstdint>
namespace cg = cooperative_groups;

#ifndef N_LAUNCH_MODE
#define N_LAUNCH_MODE 1
#endif

#ifndef P7_REPEAT
#define P7_REPEAT 1
#endif
#ifndef P4_REPEAT
#define P4_REPEAT 1
#endif
#define LAS __attribute__((address_space(3)))
typedef unsigned short bf16_t;
typedef short bf16x8 __attribute__((ext_vector_type(8)));
typedef short s16x4 __attribute__((ext_vector_type(4)));
typedef float f32x4 __attribute__((ext_vector_type(4)));
typedef float f32x2 __attribute__((ext_vector_type(2)));
typedef float f32x16 __attribute__((ext_vector_type(16)));
typedef unsigned u32x4 __attribute__((ext_vector_type(4)));
typedef unsigned u32x2 __attribute__((ext_vector_type(2)));

constexpr int TP = 65536, TS = 1024, T = TP + TS;
constexpr int SEQ = 2048, DSEQ = 32, PAST = 2048, SK = 2080;
constexpr int DM = 1024, NIN = 2304, DFF = 2816, DFF2 = 5632;
constexpr float ALPHA = 1.189207115002721f;
constexpr float EPS = 1e-5f;
constexpr float L2E = 1.4426950408889634f;

constexpr size_t MiB = 1u << 20;
constexpr size_t WS_CTL = 0, WS_ROPE = 64 * 1024, WS_CTAB = 576 * 1024;
constexpr size_t WS_WIN = 1 * MiB, WS_WUQ = 6 * MiB, WS_WUKV = 6 * MiB + 512 * 1024, WS_WO = 7 * MiB, WS_WUP = 9 * MiB, WS_WDN = 20 * MiB, WS_WG = 26 * MiB, WS_WPP = 28 * MiB;
constexpr size_t WS_PB = 32 * MiB, WS_PROJ = 65 * MiB, WS_H = 65 * MiB, WS_XB = 358 * MiB, WS_CQB = 358 * MiB, WS_CALLP = 391 * MiB, WS_CALLS = 423 * MiB;
constexpr size_t WS_MIX = 358 * MiB, WS_PP = 358 * MiB, WS_DKS = 488 * MiB, WS_DVS = 554 * MiB, WS_QA = 620 * MiB, WS_KVP = 718 * MiB, WS_KVS = 846 * MiB;
constexpr size_t WS_KRBP = 977 * MiB, WS_KRBS = 981 * MiB, WS_H1B = 488 * MiB, WS_ACT = 620 * MiB, WS_H2B = 488 * MiB, WS_PARK = 986 * MiB, WS_USPEC = 1018 * MiB, WS_END = 1024 * MiB;

constexpr int NWAVES = 8, NTHR = 512;
constexpr int LDS_BYTES = 131072 + 4096;

__constant__ float ROPE_INV[16] = {1.0f, 0.5623413324356079f, 0.3162277638912201f, 0.17782793939113617f, 0.10000000149011612f, 0.05623412877321243f, 0.03162277862429619f,
    0.017782794311642647f, 0.009999999776482582f, 0.005623413249850273f, 0.003162277862429619f, 0.0017782794311642647f, 0.0010000000474974513f, 0.000562341301701963f,
    0.0003162277862429619f, 0.00017782794020604342f};

__device__ __forceinline__ unsigned pk2(float lo, float hi) { typedef __bf16 bf2 __attribute__((ext_vector_type(2))); f32x2 v = {lo, hi}; bf2 b = __builtin_convertvector(v, bf2); return __builtin_bit_cast(unsigned, b); }
__device__ __forceinline__ float bflo(unsigned u) { return __uint_as_float(u << 16); }
__device__ __forceinline__ float bfhi(unsigned u) { return __uint_as_float(u & 0xffff0000u); }
__device__ __forceinline__ float wave_sum(float v) {
#pragma unroll
    for (int o = 1; o < 64; o <<= 1) v += __shfl_xor(v, o);
    return v;
}
#define LDS_WAIT() asm volatile("s_waitcnt lgkmcnt(0)" ::: "memory")
__device__ __forceinline__ int lane_id() { int l; asm volatile("v_mbcnt_lo_u32_b32 %0, -1, 0\n\tv_mbcnt_hi_u32_b32 %0, -1, %0" : "=v"(l)); return l; }
__device__ __forceinline__ f32x2 gelu_pk(f32x2 v) {
    const f32x2 av = __builtin_elementwise_abs(v), d = av * 0.2316418882f + 1.0f;
    f32x2 t; t.x = __builtin_amdgcn_rcpf(d.x); t.y = __builtin_amdgcn_rcpf(d.y);
    f32x2 q = t * 0.5307027145f + (-0.7265760135f); q = q * t + 0.7107068705f; q = q * t + (-0.142248368f); q = q * t + 0.127414796f; q = q * t;
    const f32x2 s = (v * v) * (-0.72134752044f);
    f32x2 e; e.x = __builtin_amdgcn_exp2f(s.x); e.y = __builtin_amdgcn_exp2f(s.y);
    const f32x2 m = v * (q * e), r = v - m;
    f32x2 o; o.x = v.x < 0.f ? m.x : r.x; o.y = v.y < 0.f ? m.y : r.y; return o;
}

namespace pg8 {
constexpr int BM = 256, BK = 64, HALF = 128, HTB = HALF * BK * 2, STAGE_BYTES = 8 * HTB, NXCD = 8, WGM = 8;
__device__ __forceinline__ int lds_byte(int r, int c) { const int st = (r >> 4) * 2 + (c >> 5), rr = r & 15, cc = c & 31, ob = rr * 64 + cc * 2; return st * 1024 + (ob ^ (((ob >> 9) & 1) << 5)); }
__device__ __forceinline__ void stage_rc(int b, int& R, int& C) { const int st = b / 1024, sb = b % 1024, swz = sb ^ (((sb >> 9) & 1) << 5); R = (st >> 1) * 16 + swz / 64; C = (st & 1) * 32 + (swz % 64) / 2; }
__device__ __forceinline__ int perm32(int rho) { const int n = rho >> 4, i = rho & 15; return 8 * (i >> 2) + 4 * n + (i & 3); }

struct Unit { int pm, pn; };
struct Gemm { const bf16_t* A; const bf16_t* Bt; int lda, K; };

struct StaticOrder {
    int nM, nN, nwg, G, c;
    __device__ void init(int nM_, int nN_, int G_, int c_) { nM = nM_; nN = nN_; nwg = nM * nN; G = G_; c = c_; }
    __device__ bool next(int i, Unit& u) const {
        const long L = (long)i * G + c; if (L >= nwg) return false;
        int wgid = (int)L; { const int q = nwg / NXCD, r = nwg % NXCD, xcd = wgid % NXCD, off = wgid / NXCD; wgid = (xcd < r ? xcd * (q + 1) : r * (q + 1) + (xcd - r) * q) + off; }
        const int nig = WGM * nN, gid = wgid / nig, fm = gid * WGM, gsz = (nM - fm) < WGM ? (nM - fm) : WGM;
        u.pm = fm + ((wgid % nig) % gsz); u.pn = (wgid % nig) / gsz; return true;
    }
};

template <class Epi, int AMAP>
__device__ __forceinline__ void gemm_phase(LAS unsigned char* lds, const Gemm g, const StaticOrder& S, const Epi& E, int wid) {
    const int lane = lane_id(), tid = wid * 64 + lane, wr = wid >> 2, wc = wid & 3, fr = lane & 15, fq = lane >> 4;
    const int K = g.K, nt = K / BK, lda = g.lda;
    unsigned voffA[2], voffB[2];
#pragma unroll
    for (int i = 0; i < 2; ++i) { int R, C; stage_rc(tid * 16 + i * 8192, R, C); const int Rb = (R & ~31) + perm32(R & 31);
        const int Ra = AMAP == 0 ? R : (126 * (R >> 6) + 8 * (R & 15) + ((R >> 4) & 3));
        voffA[i] = (unsigned)(Ra * lda + C) * 2u; voffB[i] = (unsigned)(Rb * K + C) * 2u; }
    const size_t kstep = (size_t)(BK * 2);
    const size_t hstepA = AMAP == 0 ? (size_t)HALF * lda * 2 : (size_t)4 * lda * 2;
    const size_t tstepA = AMAP == 0 ? (size_t)BM * lda * 2 : (size_t)252 * lda * 2;
    const size_t hstepB = (size_t)HALF * K * 2, tstepB = 2 * hstepB;
    const unsigned ldsw = (unsigned)wid * 1024u;
    const int aoff = lds_byte(wr * 64 + fr, fq * 8), boff = lds_byte(wc * 32 + fr, fq * 8);
#define PG8_SA(b, h) (((b) * 2 + (h)) * HTB)
#define PG8_SB(b, h) ((4 + (b) * 2 + (h)) * HTB)
#define PG8_STAGE(bufoff, gbase, voff) do { _Pragma("unroll") for (int _i = 0; _i < 2; ++_i) \
        __builtin_amdgcn_global_load_lds((const unsigned*)((const char*)(gbase) + (voff)[_i]), (LAS unsigned*)(lds + (bufoff) + ldsw + _i * 8192), 16, 0, 0); } while (0)
#define PG8_LDA(dst, b, h) do { _Pragma("unroll") for (int m = 0; m < 4; ++m) _Pragma("unroll") for (int k = 0; k < 2; ++k) dst[m][k] = *(const LAS bf16x8*)(lds + PG8_SA(b, h) + aoff + m * 2048 + k * 1024); } while (0)
#define PG8_LDB(dst, b, h) do { _Pragma("unroll") for (int n = 0; n < 2; ++n) _Pragma("unroll") for (int k = 0; k < 2; ++k) dst[n][k] = *(const LAS bf16x8*)(lds + PG8_SB(b, h) + boff + n * 2048 + k * 1024); } while (0)
#define PG8_MMA(ai, bj, At, Bt) do { __builtin_amdgcn_s_setprio(1); _Pragma("unroll") for (int m = 0; m < 4; ++m) _Pragma("unroll") for (int n = 0; n < 2; ++n) _Pragma("unroll") for (int k = 0; k < 2; ++k) \
        acc[ai][bj][m][n] = __builtin_amdgcn_mfma_f32_16x16x32_bf16(Bt[n][k], At[m][k], acc[ai][bj][m][n], 0, 0, 0); __builtin_amdgcn_s_setprio(0); } while (0)
#define PG8_WAIT_V(n) asm volatile("s_waitcnt vmcnt(" #n ")" ::: "memory")
#define PG8_WAIT_L(n) asm volatile("s_waitcnt lgkmcnt(" #n ")" ::: "memory")
#define PG8_BAR __builtin_amdgcn_s_barrier()
#define PG8_SCHED __builtin_amdgcn_sched_barrier(0)
    Unit cur, nxt; int ui = 0;
    if (!S.next(0, cur)) return;
    f32x4 acc[2][2][4][2];
#pragma unroll
    for (int a = 0; a < 2; ++a)
#pragma unroll
        for (int b = 0; b < 2; ++b)
#pragma unroll
            for (int m = 0; m < 4; ++m)
#pragma unroll
                for (int n = 0; n < 2; ++n) acc[a][b][m][n] = (f32x4){0.f, 0.f, 0.f, 0.f};
    bf16x8 At[4][2], B0[2][2], B1[2][2];
    const char* cA = (const char*)g.A + (size_t)cur.pm * tstepA; const char* cB = (const char*)g.Bt + (size_t)cur.pn * tstepB;
    PG8_STAGE(PG8_SB(0, 0), cB, voffB); PG8_STAGE(PG8_SB(0, 1), cB + hstepB, voffB); PG8_STAGE(PG8_SA(0, 0), cA, voffA); PG8_STAGE(PG8_SA(0, 1), cA + hstepA, voffA);
    if (wr == 1) PG8_BAR;
    PG8_WAIT_V(2); PG8_BAR;
    PG8_STAGE(PG8_SB(1, 0), cB + kstep, voffB); PG8_STAGE(PG8_SA(1, 0), cA + kstep, voffA); PG8_STAGE(PG8_SB(1, 1), cB + hstepB + kstep, voffB);
    PG8_WAIT_V(6); PG8_BAR;
    for (;;) {
        const bool has_next = S.next(ui + 1, nxt);
        const char* nA = has_next ? (const char*)g.A + (size_t)nxt.pm * tstepA : cA; const char* nB = has_next ? (const char*)g.Bt + (size_t)nxt.pn * tstepB : cB;
#pragma unroll 1
        for (int t = 0; t < nt; t += 2) {
            const bool last = (t == nt - 2);
            const char* a1 = cA + (size_t)(t + 1) * kstep;
            const char* a2 = last ? nA : cA + (size_t)(t + 2) * kstep; const char* b2 = last ? nB : cB + (size_t)(t + 2) * kstep;
            const char* a3 = a2 + kstep; const char* b3 = b2 + kstep;
            PG8_LDB(B0, 0, 0); PG8_LDB(B1, 0, 1); PG8_SCHED; PG8_LDA(At, 0, 0); PG8_STAGE(PG8_SA(1, 1), a1 + hstepA, voffA);
            PG8_WAIT_V(8); PG8_WAIT_L(0); PG8_BAR; PG8_MMA(0, 0, At, B0); PG8_MMA(0, 1, At, B1); PG8_BAR; PG8_SCHED;
            PG8_LDA(At, 0, 1); PG8_STAGE(PG8_SB(0, 0), b2, voffB); PG8_STAGE(PG8_SB(0, 1), b2 + hstepB, voffB); PG8_STAGE(PG8_SA(0, 0), a2, voffA);
            PG8_WAIT_V(8); PG8_WAIT_L(0); PG8_BAR; PG8_MMA(1, 0, At, B0); PG8_MMA(1, 1, At, B1); PG8_BAR; PG8_SCHED;
            PG8_LDB(B0, 1, 0); PG8_LDB(B1, 1, 1); PG8_SCHED; PG8_LDA(At, 1, 0); PG8_STAGE(PG8_SA(0, 1), a2 + hstepA, voffA);
            PG8_WAIT_V(8); PG8_WAIT_L(0); PG8_BAR; PG8_MMA(0, 0, At, B0); PG8_MMA(0, 1, At, B1); PG8_BAR; PG8_SCHED;
            PG8_LDA(At, 1, 1); PG8_STAGE(PG8_SB(1, 0), b3, voffB); PG8_STAGE(PG8_SB(1, 1), b3 + hstepB, voffB); PG8_STAGE(PG8_SA(1, 0), a3, voffA);
            PG8_WAIT_V(8); PG8_WAIT_L(0); PG8_BAR; PG8_MMA(1, 0, At, B0); PG8_MMA(1, 1, At, B1); PG8_BAR; PG8_SCHED;
        }
        if (wr == 0) PG8_BAR;
        E(acc, cur, wr, wc, fr, fq);
        if (!has_next) break;
#pragma unroll
        for (int a = 0; a < 2; ++a)
#pragma unroll
            for (int b = 0; b < 2; ++b)
#pragma unroll
                for (int m = 0; m < 4; ++m)
#pragma unroll
                    for (int n = 0; n < 2; ++n) acc[a][b][m][n] = (f32x4){0.f, 0.f, 0.f, 0.f};
        cur = nxt; cA = nA; cB = nB; ++ui;
        if (wr == 1) PG8_BAR;
    }
    PG8_WAIT_V(0);
    PG8_BAR;
#undef PG8_SA
#undef PG8_SB
#undef PG8_STAGE
#undef PG8_LDA
#undef PG8_LDB
#undef PG8_MMA
#undef PG8_WAIT_V
#undef PG8_WAIT_L
#undef PG8_BAR
#undef PG8_SCHED
}

struct EpiBf16 {
    bf16_t* O; int ldc;
    __device__ __forceinline__ void operator()(f32x4 (&acc)[2][2][4][2], const Unit& u, int wr, int wc, int fr, int fq) const {
        const int row0 = u.pm * BM + wr * 64 + fr, col0 = u.pn * BM + wc * 32 + 8 * fq;
#pragma unroll
        for (int ai = 0; ai < 2; ++ai)
#pragma unroll
            for (int m = 0; m < 4; ++m) { bf16_t* rowp = O + (size_t)(row0 + ai * HALF + m * 16) * ldc + col0;
#pragma unroll
                for (int bj = 0; bj < 2; ++bj) { const f32x4 v0 = acc[ai][bj][m][0], v1 = acc[ai][bj][m][1];
                    u32x4 w; w.x = pk2(v0[0], v0[1]); w.y = pk2(v0[2], v0[3]); w.z = pk2(v1[0], v1[1]); w.w = pk2(v1[2], v1[3]);
                    *(u32x4*)(rowp + bj * HALF) = w; } }
    }
};
struct EpiProj {
    bf16_t* O; float* dkp; float* dks_o; float* dvp; float* dvs_o;
    __device__ __forceinline__ void operator()(f32x4 (&acc)[2][2][4][2], const Unit& u, int wr, int wc, int fr, int fq) const {
        const int row0 = u.pm * BM + wr * 64 + fr, col0 = u.pn * BM + wc * 32 + 8 * fq;
        float* fo = nullptr;
        if (u.pn >= 4 && u.pn < 8) { const bool samp = u.pm * BM >= TP; const int c0 = col0 - (u.pn < 6 ? 1024 : 1536);
            fo = (u.pn < 6 ? (samp ? dks_o - (size_t)TP * 512 : dkp) : (samp ? dvs_o - (size_t)TP * 512 : dvp)) + c0; }
#pragma unroll
        for (int ai = 0; ai < 2; ++ai)
#pragma unroll
            for (int m = 0; m < 4; ++m) { const int row = row0 + ai * HALF + m * 16; bf16_t* rowp = O + (size_t)row * NIN + col0;
#pragma unroll
                for (int bj = 0; bj < 2; ++bj) { const f32x4 v0 = acc[ai][bj][m][0], v1 = acc[ai][bj][m][1];
                    u32x4 w; w.x = pk2(v0[0], v0[1]); w.y = pk2(v0[2], v0[3]); w.z = pk2(v1[0], v1[1]); w.w = pk2(v1[2], v1[3]);
                    *(u32x4*)(rowp + bj * HALF) = w; } }
        if (fo) {
            asm volatile("" ::: "memory");
#pragma unroll
            for (int ai = 0; ai < 2; ++ai)
#pragma unroll
                for (int m = 0; m < 4; ++m) { float* fp = fo + (size_t)(row0 + ai * HALF + m * 16) * 512;
#pragma unroll
                    for (int bj = 0; bj < 2; ++bj) { __builtin_nontemporal_store(acc[ai][bj][m][0], (f32x4*)(fp + bj * HALF)); __builtin_nontemporal_store(acc[ai][bj][m][1], (f32x4*)(fp + bj * HALF + 4)); }
                    if (m & 1) asm volatile("" ::: "memory"); }
        }
    }
};
struct EpiResX {
    const float* xp; const float* xs; float* h;
    __device__ __forceinline__ void operator()(f32x4 (&acc)[2][2][4][2], const Unit& u, int wr, int wc, int fr, int fq) const {
        const int row0 = u.pm * BM + wr * 64 + fr, col0 = u.pn * BM + wc * 32 + 8 * fq;
        const float* xb = (u.pm * BM < TP) ? xp : xs - (size_t)TP * DM;
#pragma unroll
        for (int ai = 0; ai < 2; ++ai)
#pragma unroll
            for (int m = 0; m < 4; ++m) { const size_t off = (size_t)(row0 + ai * HALF + m * 16) * DM + col0;
#pragma unroll
                for (int bj = 0; bj < 2; ++bj) {
                    const f32x4 x0 = *(const f32x4*)(xb + off + bj * HALF), x1 = *(const f32x4*)(xb + off + bj * HALF + 4);
                    *(f32x4*)(h + off + bj * HALF) = x0 * ALPHA + acc[ai][bj][m][0]; *(f32x4*)(h + off + bj * HALF + 4) = x1 * ALPHA + acc[ai][bj][m][1]; } }
    }
};
struct EpiResH {
    float* h; const float* stat; const float* g; const float* bt;
    __device__ __forceinline__ void operator()(f32x4 (&acc)[2][2][4][2], const Unit& u, int wr, int wc, int fr, int fq) const {
        const int row0 = u.pm * BM + wr * 64 + fr, col0 = u.pn * BM + wc * 32 + 8 * fq;
#pragma unroll
        for (int bj = 0; bj < 2; ++bj) {
            const f32x4 g0 = *(const f32x4*)(g + col0 + bj * HALF), g1 = *(const f32x4*)(g + col0 + bj * HALF + 4), b0 = *(const f32x4*)(bt + col0 + bj * HALF), b1 = *(const f32x4*)(bt + col0 + bj * HALF + 4);
#pragma unroll
            for (int ai = 0; ai < 2; ++ai)
#pragma unroll
                for (int m = 0; m < 4; ++m) { const int row = row0 + ai * HALF + m * 16; const size_t off = (size_t)row * DM + col0 + bj * HALF;
                    const f32x2 st = *(const f32x2*)(stat + 2 * (size_t)row);
                    const f32x4 x0 = *(const f32x4*)(h + off), x1 = *(const f32x4*)(h + off + 4);
                    *(f32x4*)(h + off) = ((x0 - st.x) * st.y * g0 + b0) * ALPHA + acc[ai][bj][m][0]; *(f32x4*)(h + off + 4) = ((x1 - st.x) * st.y * g1 + b1) * ALPHA + acc[ai][bj][m][1]; }
        }
    }
};
struct EpiGate {
    const float* h2; const bf16_t* pp; const float* bias; float* yp; float* ys; const float* stat; const float* g; const float* bt;
    __device__ __forceinline__ void operator()(f32x4 (&acc)[2][2][4][2], const Unit& u, int wr, int wc, int fr, int fq) const {
        const int row0 = u.pm * BM + wr * 64 + fr, col0 = u.pn * BM + wc * 32 + 8 * fq;
        float* yb = (u.pm * BM < TP) ? yp : ys - (size_t)TP * DM;
#pragma unroll
        for (int bj = 0; bj < 2; ++bj) {
            const f32x4 b0 = *(const f32x4*)(bias + col0 + bj * HALF), b1 = *(const f32x4*)(bias + col0 + bj * HALF + 4);
            const f32x4 lg0 = *(const f32x4*)(g + col0 + bj * HALF), lg1 = *(const f32x4*)(g + col0 + bj * HALF + 4), lb0 = *(const f32x4*)(bt + col0 + bj * HALF), lb1 = *(const f32x4*)(bt + col0 + bj * HALF + 4);
#pragma unroll
            for (int ai = 0; ai < 2; ++ai)
#pragma unroll
                for (int m = 0; m < 4; ++m) { const int row = row0 + ai * HALF + m * 16; const size_t off = (size_t)row * DM + col0 + bj * HALF;
                    const f32x2 st = *(const f32x2*)(stat + 2 * (size_t)row);
                    const f32x4 h0 = (*(const f32x4*)(h2 + off) - st.x) * st.y * lg0 + lb0, h1 = (*(const f32x4*)(h2 + off + 4) - st.x) * st.y * lg1 + lb1;
                    const u32x4 pw = *(const u32x4*)(pp + off);
                    const f32x4 p0 = {bflo(pw.x), bfhi(pw.x), bflo(pw.y), bfhi(pw.y)}, p1 = {bflo(pw.z), bfhi(pw.z), bflo(pw.w), bfhi(pw.w)};
                    f32x4 g0 = acc[ai][bj][m][0] + b0, g1 = acc[ai][bj][m][1] + b1;
#pragma unroll
                    for (int e = 0; e < 4; ++e) { g0[e] = __builtin_amdgcn_rcpf(1.f + __builtin_amdgcn_exp2f(-g0[e] * L2E)); g1[e] = __builtin_amdgcn_rcpf(1.f + __builtin_amdgcn_exp2f(-g1[e] * L2E)); }
                    __builtin_nontemporal_store(h0 + g0 * p0, (f32x4*)(yb + off)); __builtin_nontemporal_store(h1 + g1 * p1, (f32x4*)(yb + off + 4)); }
        }
    }
};
__device__ __forceinline__ float dpp_shr1(float v) { float r; asm volatile("s_nop 1\n\tv_mov_b32_dpp %0, %1 row_shr:1 row_mask:0xf bank_mask:0xf\n\ts_nop 1" : "=v"(r) : "v"(v)); return r; }
struct EpiConvGlu {
    bf16_t* act; const float* ctab; float* uspec;
    __device__ __forceinline__ void operator()(f32x4 (&acc)[2][2][4][2], const Unit& u, int wr, int wc, int fr, int fq) const {
        const int tok0 = 252 * u.pm + 126 * wr - 2 + 8 * fr;
        const int j0 = 128 * u.pn + 32 * wc + 8 * fq;
        const int x = tok0 - 1;
        const int rem = x < TP ? ((2048 - (x & 2047)) & 2047) : ((32 - ((x - TP) & 31)) & 31);
        const int s = x + rem; int ks = rem - 1; if (ks > 9 || s > T) ks = 100;
        const int kmin = fr == 0 ? 2 : 0, kmax = T - tok0;
        if (ks <= 9) {
            const int si = s <= TP ? (s >> 11) : 32 + ((s - TP) >> 5);
            float* o = uspec + (size_t)si * 4 * DFF2 + j0;
#pragma unroll
            for (int k = 0; k < 8; ++k) { const int d = k - ks + 2;
                if (k >= kmin && k < kmax && (unsigned)d < 4u) { float* od = o + (size_t)d * DFF2;
                    *(f32x4*)od = acc[k >> 2][0][k & 3][0]; *(f32x4*)(od + 4) = acc[k >> 2][0][k & 3][1]; *(f32x4*)(od + DFF) = acc[k >> 2][1][k & 3][0]; *(f32x4*)(od + DFF + 4) = acc[k >> 2][1][k & 3][1]; } }
        }
        asm volatile("" ::: "memory");
#pragma unroll
        for (int n = 0; n < 2; ++n) {
            const f32x4* tab = (const f32x4*)(ctab + (size_t)(j0 + 4 * n) * 8);
            const f32x4 wg0 = tab[0], wg1 = tab[1], wg2 = tab[2], bg = tab[3], wv0 = tab[4], wv1 = tab[5], wv2 = tab[6], bv = tab[7];
            f32x4 p1g, p2g, p1v, p2v;
#pragma unroll
            for (int e = 0; e < 4; ++e) { p1g[e] = dpp_shr1(acc[1][0][3][n][e]); p2g[e] = dpp_shr1(acc[1][0][2][n][e]); p1v[e] = dpp_shr1(acc[1][1][3][n][e]); p2v[e] = dpp_shr1(acc[1][1][2][n][e]); }
#pragma unroll
            for (int k = 0; k < 8; ++k) {
                const f32x4 cg = acc[k >> 2][0][k & 3][n], cv = acc[k >> 2][1][k & 3][n];
                const f32x4 zg = bg + wg0 * p2g + wg1 * p1g + wg2 * cg, zv = bv + wv0 * p2v + wv1 * p1v + wv2 * cv;
                p2g = p1g; p1g = cg; p2v = p1v; p1v = cv;
                const f32x2 r0 = gelu_pk((f32x2){zg[0], zg[1]}) * (f32x2){zv[0], zv[1]}, r1 = gelu_pk((f32x2){zg[2], zg[3]}) * (f32x2){zv[2], zv[3]};
                if (k >= kmin && k < kmax && (unsigned)(k - ks) >= 2u) {
                    u32x2 w; w.x = pk2(r0.x, r0.y); w.y = pk2(r1.x, r1.y);
                    *(u32x2*)(act + (size_t)(tok0 + k) * DFF + j0 + 4 * n) = w; }
            }
            asm volatile("" ::: "memory");
        }
    }
};
}

#define MFMA32(a, b, c) __builtin_amdgcn_mfma_f32_32x32x16_bf16((a), (b), (c), 0, 0, 0)
__device__ __forceinline__ float max3f(float a, float b, float c) { float r; asm("v_max3_f32 %0, %1, %2, %3" : "=v"(r) : "v"(a), "v"(b), "v"(c)); return r; }
__device__ __forceinline__ float max2f(float a, float b) { float r; asm("v_max_f32_e32 %0, %1, %2" : "=v"(r) : "v"(a), "v"(b)); return r; }
__device__ __forceinline__ float shfl32(float v) { return __int_as_float(__builtin_amdgcn_ds_bpermute((lane_id() ^ 32) << 2, __float_as_int(v))); }
__device__ __forceinline__ int crow(int r, int hi) { return (r & 3) + 8 * (r >> 2) + 4 * hi; }
__device__ __forceinline__ bf16x8 pack8(const f32x16& p, int o) {
    u32x4 w; w.x = pk2(p[o], p[o + 1]); w.y = pk2(p[o + 2], p[o + 3]); w.z = pk2(p[o + 4], p[o + 5]); w.w = pk2(p[o + 6], p[o + 7]); return __builtin_bit_cast(bf16x8, w);
}
template <int DK, int DV, bool MLA, bool ALIBI, bool QL>
__device__ __forceinline__ void flash_pass(LAS unsigned char* lds, const bf16x8 (&qf)[DK / 16], const bf16_t* Kg, int kpitch, const bf16_t* KRg, const bf16_t* Vg, int vpitch,
                                           int nt_unit, int nt_wave, int nvalid_last, float scale_l2e, float slope_l2e, int qpos, int kpos0, f32x16 (&O)[DV / 32], float& lsum, int wv) {
    constexpr int KP = DK * 2 + 16, VP = DV * 2 + 64, KBUF = 64 * KP, VBUF = 64 * VP, BUF = KBUF + VBUF, NV = DV / 64, VCH = DV / 8;
    const int lane = lane_id(), tid = wv * 64 + lane, r32 = lane & 31, hi = lane >> 5;
    const int krow = tid >> 3, kch = tid & 7, rrow = (tid & 255) >> 2, rch = tid & 3;
    const unsigned koffb = (unsigned)(krow * kpitch + kch * 8) * 2u, kroffb = (unsigned)(rrow * 32 + rch * 8) * 2u;
    unsigned voffb[NV];
#pragma unroll
    for (int i = 0; i < NV; ++i) { const int idx = tid + 512 * i; voffb[i] = (unsigned)((idx / VCH) * vpitch + (idx % VCH) * 8) * 2u; }
    u32x4 kreg[2], krreg[2] = {{0, 0, 0, 0}, {0, 0, 0, 0}}, vreg[2][NV];
#define FP_GLOAD(t, P) do { kreg[P] = *(const u32x4*)((const char*)Kg + (size_t)(t) * 128 * kpitch + koffb); if (MLA && tid < 256) krreg[P] = *(const u32x4*)((const char*)KRg + (size_t)(t) * 4096 + kroffb); \
        _Pragma("unroll") for (int _i = 0; _i < NV; ++_i) vreg[P][_i] = *(const u32x4*)((const char*)Vg + (size_t)(t) * 128 * vpitch + voffb[_i]); } while (0)
#define FP_LSTORE(buf, P) do { LAS unsigned char* kb_ = lds + (buf) * BUF; *(LAS u32x4*)(kb_ + krow * KP + kch * 16) = kreg[P]; if (MLA && tid < 256) *(LAS u32x4*)(kb_ + rrow * KP + 128 + rch * 16) = krreg[P]; \
        _Pragma("unroll") for (int _i = 0; _i < NV; ++_i) { const int idx = tid + 512 * _i; *(LAS u32x4*)(kb_ + KBUF + (idx / VCH) * VP + (idx % VCH) * 16) = vreg[P][_i]; } } while (0)
    float m = -1e30f, l = 0.f;
#pragma unroll
    for (int b = 0; b < DV / 32; ++b)
#pragma unroll
        for (int r = 0; r < 16; ++r) O[b][r] = 0.f;
    constexpr bool TWO = true;
    FP_GLOAD(0, 0); if (TWO && nt_unit > 1) FP_GLOAD(1, 1);
    FP_LSTORE(0, 0);
    LAS unsigned char* qlds = lds + 2 * BUF + wv * (DK / 16) * 1024 + lane * 16;
    if (QL) {
#pragma unroll
        for (int s = 0; s < DK / 16; ++s) *(LAS bf16x8*)(qlds + s * 1024) = qf[s];
    }
    __syncthreads();
    const int q4 = (lane & 15) >> 2, p4 = lane & 3, cg16 = (lane >> 4) & 1;
    for (int t2 = 0; t2 < nt_unit; t2 += 2)
#pragma unroll
    for (int par = 0; par < 2; ++par) {
        const int t = t2 + par;
        if (t >= nt_unit) break;
        const bool more = t + 1 < nt_unit;
        if (TWO) { if (t + 2 < nt_unit) FP_GLOAD(t + 2, par); }
        else { if (more) FP_GLOAD(t + 1, 0); }
        if (t < nt_wave) {
            LAS const unsigned char* kb = lds + (t & 1) * BUF; LAS const unsigned char* vb = kb + KBUF;
            constexpr int KH = (DV > 64) ? DK / 32 : DK / 16;
            bf16x8 kf[2 * KH];
#pragma unroll
            for (int s = 0; s < KH; ++s) { kf[2 * s] = *(LAS const bf16x8*)(kb + r32 * KP + s * 32 + hi * 16); kf[2 * s + 1] = *(LAS const bf16x8*)(kb + (32 + r32) * KP + s * 32 + hi * 16); }
            s16x4 vf[4][DV / 32][2];
            LAS const unsigned char* vad = vb + (4 * hi + q4) * VP + (16 * cg16) * 2 + 8 * p4;
#define FP_VLOAD(s) do { _Pragma("unroll") for (int b = 0; b < DV / 32; ++b) { vf[s][b][0] = __builtin_amdgcn_ds_read_tr16_b64_v4i16((LAS s16x4*)(vad + 16 * (s) * VP + 64 * b)); \
                vf[s][b][1] = __builtin_amdgcn_ds_read_tr16_b64_v4i16((LAS s16x4*)(vad + (16 * (s) + 8) * VP + 64 * b)); } } while (0)
            FP_VLOAD(0);
            __builtin_amdgcn_sched_barrier(0);
            f32x16 p0, p1;
#pragma unroll
            for (int r = 0; r < 16; ++r) { p0[r] = 0.f; p1[r] = 0.f; }
#pragma unroll
            for (int s = 0; s < KH; ++s) { const bf16x8 q = QL ? *(LAS const bf16x8*)(qlds + s * 1024) : qf[s]; p0 = MFMA32(kf[2 * s], q, p0); p1 = MFMA32(kf[2 * s + 1], q, p1); }
            if (KH < DK / 16) {
                __builtin_amdgcn_sched_barrier(0);
#pragma unroll
                for (int s = 0; s < KH; ++s) { kf[2 * s] = *(LAS const bf16x8*)(kb + r32 * KP + (s + KH) * 32 + hi * 16); kf[2 * s + 1] = *(LAS const bf16x8*)(kb + (32 + r32) * KP + (s + KH) * 32 + hi * 16); }
                __builtin_amdgcn_sched_barrier(0);
#pragma unroll
                for (int s = 0; s < KH; ++s) { const bf16x8 q = QL ? *(LAS const bf16x8*)(qlds + (s + KH) * 1024) : qf[s + KH]; p0 = MFMA32(kf[2 * s], q, p0); p1 = MFMA32(kf[2 * s + 1], q, p1); }
            }
            __builtin_amdgcn_sched_barrier(0);
            if (DV <= 64) FP_VLOAD(1);
            __builtin_amdgcn_sched_barrier(0);
            const int kbase = kpos0 + t * 64;
            if (ALIBI) {
                if (t < nt_wave - 1) {
                    const float cb = slope_l2e * (float)(kbase + 4 * hi - qpos);
#pragma unroll
                    for (int r = 0; r < 16; ++r) { const float bs = cb + slope_l2e * (float)((r & 3) + 8 * (r >> 2)); p0[r] = p0[r] * scale_l2e + bs; p1[r] = p1[r] * scale_l2e + (bs + 32.f * slope_l2e); }
                } else {
#pragma unroll
                    for (int r = 0; r < 16; ++r) { const int kp = kbase + crow(r, hi); p0[r] = p0[r] * scale_l2e - slope_l2e * fabsf((float)(qpos - kp)); p1[r] = p1[r] * scale_l2e - slope_l2e * fabsf((float)(qpos - kp - 32)); }
                }
            } else {
#pragma unroll
                for (int r = 0; r < 16; ++r) { p0[r] *= scale_l2e; p1[r] *= scale_l2e; }
            }
            if (nvalid_last < 64 && t == nt_unit - 1) {
                asm volatile("" ::: "memory");
#pragma unroll
                for (int r = 0; r < 16; ++r) { const int kv = crow(r, hi); if (kv >= nvalid_last) p0[r] = -INFINITY; if (kv + 32 >= nvalid_last) p1[r] = -INFINITY; }
            }
            float mx = max2f(p0[0], p1[0]);
#pragma unroll
            for (int r = 1; r < 16; ++r) mx = max3f(mx, p0[r], p1[r]);
            mx = max2f(mx, shfl32(mx));
            const float mnew = max2f(m, mx);
            if (__builtin_amdgcn_ballot_w64(mnew != m) != 0ull) {
                const float alpha = __builtin_amdgcn_exp2f(m - mnew); m = mnew; l *= alpha;
#pragma unroll
                for (int b = 0; b < DV / 32; ++b)
#pragma unroll
                    for (int r = 0; r < 16; ++r) O[b][r] *= alpha;
            }
            float rs = 0.f;
            __builtin_amdgcn_sched_barrier(0);
#pragma unroll
            for (int s = 0; s < 4; ++s) {
                if (DV <= 64) { if (s == 0) FP_VLOAD(2); if (s == 1) FP_VLOAD(3); }
                else { if (s == 0) FP_VLOAD(1); if (s == 1) FP_VLOAD(2); if (s == 2) FP_VLOAD(3); }
                float e[8];
#pragma unroll
                for (int i = 0; i < 8; ++i) { e[i] = __builtin_amdgcn_exp2f((s < 2 ? p0[8 * (s & 1) + i] : p1[8 * (s & 1) + i]) - m); rs += e[i]; }
                u32x4 pw; pw.x = pk2(e[0], e[1]); pw.y = pk2(e[2], e[3]); pw.z = pk2(e[4], e[5]); pw.w = pk2(e[6], e[7]);
                const bf16x8 pb = __builtin_bit_cast(bf16x8, pw);
#pragma unroll
                for (int b = 0; b < DV / 32; ++b) {
                    const bf16x8 va = __builtin_shufflevector(vf[s][b][0], vf[s][b][1], 0, 1, 2, 3, 4, 5, 6, 7);
                    O[b] = MFMA32(va, pb, O[b]);
                }
                __builtin_amdgcn_sched_barrier(0);
            }
            l += rs;
#undef FP_VLOAD
        }
        if (more) FP_LSTORE((t + 1) & 1, TWO ? (par ^ 1) : 0);
        __syncthreads();
    }
    lsum = l;
#undef FP_GLOAD
#undef FP_LSTORE
}

template <int DK, int DV, bool MLA, bool ALIBI>
__device__ __forceinline__ void sample_pass(LAS unsigned char* lds, const bf16x8 (&qf)[DK / 16], const bf16_t* Kg, int kpitch, const bf16_t* KRg, const bf16_t* Vg, int vpitch,
                                            float scale_l2e, float slope_l2e, int qpos, f32x16 (&O)[DV / 32], float& lsum, int wv) {
    constexpr int VP = DV * 2 + 64, VBYTES = 32 * VP, NVL = DV / 16, VCH = DV / 8, NB = DV / 32, DUMP = (NB * 16 + 2) * 256;
    const int lane = lane_id(), r32 = lane & 31, hi = lane >> 5;
    LAS unsigned char* vb = lds + wv * VBYTES;
    const int q4 = (lane & 15) >> 2, p4 = lane & 3, cg16 = (lane >> 4) & 1;
    LAS const unsigned char* vad = vb + (4 * hi + q4) * VP + (16 * cg16) * 2 + 8 * p4;
    const unsigned klo = (unsigned)(r32 * kpitch + 8 * hi) * 2u, rlo = (unsigned)(r32 * 32 + 8 * hi) * 2u, vlo = (unsigned)((lane / VCH) * vpitch + (lane % VCH) * 8) * 2u;
    float m = -1e30f, l = 0.f;
#pragma unroll
    for (int b = 0; b < NB; ++b)
#pragma unroll
        for (int r = 0; r < 16; ++r) O[b][r] = 0.f;
    constexpr bool PFV = DV <= 64;
    bf16x8 kfN[DK / 16]; u32x4 vrN[NVL];
#define SP_LOAD(t) do { const char* kbt_ = (const char*)Kg + (size_t)(t) * 64 * kpitch; \
        _Pragma("unroll") for (int s_ = 0; s_ < (MLA ? 4 : DK / 16); ++s_) kfN[s_] = *(const bf16x8*)(kbt_ + klo + 32 * s_); \
        if (MLA) { const char* rr_ = (const char*)KRg + (size_t)(t) * 2048; kfN[DK / 16 - 2] = *(const bf16x8*)(rr_ + rlo); kfN[DK / 16 - 1] = *(const bf16x8*)(rr_ + rlo + 32); } \
        const char* vbt_ = (const char*)Vg + (size_t)(t) * 64 * vpitch; \
        if (PFV) { _Pragma("unroll") for (int i_ = 0; i_ < NVL; ++i_) vrN[i_] = *(const u32x4*)(vbt_ + (size_t)i_ * (64 / VCH) * vpitch * 2 + vlo); } } while (0)
    SP_LOAD(wv);
    for (int t = wv; t < 65; t += 8) {
        bf16x8 kf[DK / 16];
#pragma unroll
        for (int s = 0; s < DK / 16; ++s) kf[s] = kfN[s];
        if (PFV) {
#pragma unroll
            for (int i = 0; i < NVL; ++i) *(LAS u32x4*)(vb + ((lane / VCH) + i * (64 / VCH)) * VP + (lane % VCH) * 16) = vrN[i];
            if (t + 8 < 65) SP_LOAD(t + 8);
        } else {
            if (t + 8 < 65) SP_LOAD(t + 8);
            const char* vbt = (const char*)Vg + (size_t)t * 64 * vpitch;
#pragma unroll
            for (int i0 = 0; i0 < NVL; i0 += 4) {
                u32x4 vr[4];
#pragma unroll
                for (int i = 0; i < 4; ++i) vr[i] = *(const u32x4*)(vbt + (size_t)(i0 + i) * (64 / VCH) * vpitch * 2 + vlo);
#pragma unroll
                for (int i = 0; i < 4; ++i) *(LAS u32x4*)(vb + ((lane / VCH) + (i0 + i) * (64 / VCH)) * VP + (lane % VCH) * 16) = vr[i];
            }
        }
        f32x16 p0;
#pragma unroll
        for (int r = 0; r < 16; ++r) p0[r] = 0.f;
#pragma unroll
        for (int s = 0; s < DK / 16; ++s) p0 = MFMA32(kf[s], qf[s], p0);
#pragma unroll
        for (int r = 0; r < 16; ++r) { float x = p0[r] * scale_l2e; if (ALIBI) x -= slope_l2e * fabsf((float)(qpos - (32 * t + crow(r, hi)))); p0[r] = x; }
        float mx = max2f(p0[0], p0[1]);
#pragma unroll
        for (int r = 2; r < 16; r += 2) mx = max3f(mx, p0[r], p0[r + 1]);
        mx = max2f(mx, shfl32(mx));
        const float mnew = max2f(m, mx), alpha = __builtin_amdgcn_exp2f(m - mnew); m = mnew;
        float rs = 0.f;
#pragma unroll
        for (int r = 0; r < 16; ++r) { p0[r] = __builtin_amdgcn_exp2f(p0[r] - mnew); rs += p0[r]; }
        l = l * alpha + rs;
#pragma unroll
        for (int b = 0; b < NB; ++b)
#pragma unroll
            for (int r = 0; r < 16; ++r) O[b][r] *= alpha;
#pragma unroll
        for (int s = 0; s < 2; ++s) {
            const bf16x8 pb = pack8(p0, 8 * s);
#pragma unroll
            for (int b = 0; b < NB; ++b) {
                const s16x4 lo = __builtin_amdgcn_ds_read_tr16_b64_v4i16((LAS s16x4*)(vad + 16 * s * VP + 64 * b));
                const s16x4 hi4 = __builtin_amdgcn_ds_read_tr16_b64_v4i16((LAS s16x4*)(vad + (16 * s + 8) * VP + 64 * b));
                O[b] = MFMA32(__builtin_shufflevector(lo, hi4, 0, 1, 2, 3, 4, 5, 6, 7), pb, O[b]);
            }
        }
        asm volatile("s_waitcnt lgkmcnt(0)" ::: "memory");
    }
#undef SP_LOAD
    __syncthreads();
    if (wv > 0) {
        LAS float* d = (LAS float*)(lds + (wv - 1) * DUMP) + lane;
#pragma unroll
        for (int b = 0; b < NB; ++b)
#pragma unroll
            for (int r = 0; r < 16; ++r) d[(b * 16 + r) * 64] = O[b][r];
        d[NB * 16 * 64] = m; d[(NB * 16 + 1) * 64] = l;
    }
    __syncthreads();
    if (wv == 0) {
#pragma unroll 1
        for (int w2 = 0; w2 < 7; ++w2) {
            LAS const float* d = (LAS const float*)(lds + w2 * DUMP) + lane;
            const float m2 = d[NB * 16 * 64], l2 = d[(NB * 16 + 1) * 64];
            const float mnew = fmaxf(m, m2), a = __builtin_amdgcn_exp2f(m - mnew), a2 = __builtin_amdgcn_exp2f(m2 - mnew); m = mnew;
            l = l * a + l2 * a2;
#pragma unroll
            for (int b = 0; b < NB; ++b)
#pragma unroll
                for (int r = 0; r < 16; ++r) O[b][r] = O[b][r] * a + d[(b * 16 + r) * 64] * a2;
        }
    }
    __syncthreads();
    lsum = l;
}

struct AttnCtx {
    const bf16_t *qa, *proj, *kvp, *kvs, *krbp, *krbs, *dks, *dvs; bf16_t* mix; const float* rope; const float* g_subln; float lam; float* park;
};
template <bool samp>
__device__ __forceinline__ void diff_unit(LAS unsigned char* lds, const AttnCtx& C, int h, int w, int nt_unit, int nt_wave, int nvalid_last, bool wvalid, int qi0, unsigned qrow0, size_t krow0) {
    const int lane = lane_id(), r32 = lane & 31, hi = lane >> 5;
    const unsigned qrow = qrow0 + r32; const int qpos = (samp ? 2048 : qi0) + r32;
        const float slope = h == 0 ? 0.25f : h == 1 ? 0.0625f : h == 2 ? 0.015625f : 0.00390625f;
        const bf16_t* Kb = samp ? C.dks + krow0 * 512 + h * 128 : C.proj + krow0 * NIN + 1024 + h * 128; const int kpitch = samp ? 512 : NIN;
        const bf16_t* Vb = samp ? C.dvs + krow0 * 512 + h * 128 : C.proj + krow0 * NIN + 1536 + h * 128;
        f32x16 O1[4], O2[4]; float l1, l2;
        {
            bf16x8 qf[4]; const bf16_t* qp = C.proj + (size_t)qrow * NIN + 512 + h * 128 + 8 * hi;
#pragma unroll
            for (int s = 0; s < 4; ++s) qf[s] = *(const bf16x8*)(qp + 16 * s);
            if (samp) sample_pass<64, 128, false, true>(lds, qf, Kb, kpitch, nullptr, Vb, kpitch, 0.125f * L2E, slope * L2E, qpos, O1, l1, w);
            else flash_pass<64, 128, false, true, true>(lds, qf, Kb, kpitch, nullptr, Vb, kpitch, nt_unit, nt_wave, nvalid_last, 0.125f * L2E, slope * L2E, qpos, 0, O1, l1, w);
        }
        {
            f32x4* park = (f32x4*)(C.park + ((size_t)(blockIdx.x * NWAVES + w) * 64 + lane_id()) * 64);
            l1 += shfl32(l1); const float i1 = 1.f / l1;
#pragma unroll
            for (int bk = 0; bk < 4; ++bk)
#pragma unroll
                for (int g = 0; g < 4; ++g) park[bk * 4 + g] = (f32x4){O1[bk][4 * g] * i1, O1[bk][4 * g + 1] * i1, O1[bk][4 * g + 2] * i1, O1[bk][4 * g + 3] * i1};
        }
        {
            const int ln = lane_id();
            bf16x8 qf[4]; const bf16_t* qp = C.proj + (size_t)(qrow0 + (ln & 31)) * NIN + 512 + h * 128 + 64 + 8 * (ln >> 5);
#pragma unroll
            for (int s = 0; s < 4; ++s) qf[s] = *(const bf16x8*)(qp + 16 * s);
            if (samp) sample_pass<64, 128, false, true>(lds, qf, Kb + 64, kpitch, nullptr, Vb, kpitch, 0.125f * L2E, slope * L2E, 2048 + (ln & 31), O2, l2, w);
            else flash_pass<64, 128, false, true, true>(lds, qf, Kb + 64, kpitch, nullptr, Vb, kpitch, nt_unit, nt_wave, nvalid_last, 0.125f * L2E, slope * L2E, qi0 + (ln & 31), 0, O2, l2, w);
        }
        l2 += shfl32(l2);
        const float i2 = C.lam / l2;
        const f32x4* park = (const f32x4*)(C.park + ((size_t)(blockIdx.x * NWAVES + w) * 64 + lane_id()) * 64);
        float ss = 0.f;
#pragma unroll
        for (int bk = 0; bk < 4; ++bk)
#pragma unroll
            for (int g = 0; g < 4; ++g) { const f32x4 pv = park[bk * 4 + g];
#pragma unroll
                for (int e = 0; e < 4; ++e) { const float o = pv[e] - O2[bk][4 * g + e] * i2; O1[bk][4 * g + e] = o; ss += o * o; } }
        ss += shfl32(ss);
        const float rn = 0.8f / sqrtf(ss * (1.f / 128.f) + EPS);
        if (wvalid) {
            const int ln = lane_id(), hi2 = ln >> 5;
            bf16_t* op = C.mix + (size_t)(qrow0 + (ln & 31)) * 1024 + 512 + h * 128 + 4 * hi2;
#pragma unroll
            for (int bk = 0; bk < 4; ++bk)
#pragma unroll
                for (int g = 0; g < 4; ++g) { const f32x4 gs = *(const f32x4*)(C.g_subln + 32 * bk + 8 * g + 4 * hi2);
                    u32x2 o; o.x = pk2(O1[bk][4 * g] * rn * gs[0], O1[bk][4 * g + 1] * rn * gs[1]); o.y = pk2(O1[bk][4 * g + 2] * rn * gs[2], O1[bk][4 * g + 3] * rn * gs[3]);
                    *(u32x2*)(op + 32 * bk + 8 * g) = o; }
        }
}
constexpr int ATT_UNITS = 384 + 8 * 384;
__device__ __forceinline__ void attn_unit(LAS unsigned char* lds, const AttnCtx& C, int idx, int w) {
    const int lane = lane_id(), r32 = lane & 31, hi = lane >> 5;
    int kind, b, h, qb;
    if (idx < 128) { kind = 3; b = idx >> 2; h = idx & 3; qb = 0; }
    else if (idx < 384) { kind = 2; const int j = idx - 128; b = j >> 3; h = j & 7; qb = 0; }
    else { const int j = idx - 384; qb = 7 - j / 384; const int r = j % 384; if (r < 128) { kind = 1; b = r >> 2; h = r & 3; } else { kind = 0; b = (r - 128) >> 3; h = (r - 128) & 7; } }
    const bool samp = kind >= 2;
    const int nt_unit = samp ? 33 : 4 * qb + 4;
    const int nt_wave = samp ? (w == 0 ? 33 : 0) : 4 * qb + (w >> 1) + 1;
    const int nvalid_last = samp ? 32 : 64;
    const bool wvalid = samp ? (w == 0) : true;
    const int qi0 = samp ? 0 : 256 * qb + 32 * w;
    const unsigned qrow0 = samp ? (unsigned)(TP + b * 32) : (unsigned)(b * 2048 + qi0);
    const unsigned qrow = qrow0 + r32;
    const int qpos = (samp ? 2048 : qi0) + r32;
    const size_t krow0 = samp ? (size_t)b * SK : (size_t)b * 2048;
    if (kind == 0 || kind == 2) {
        bf16x8 qf[6];
        const bf16_t* qp = C.qa + (size_t)qrow * 768 + h * 96 + 8 * hi;
#pragma unroll
        for (int s = 0; s < 6; ++s) qf[s] = *(const bf16x8*)(qp + 16 * s);
        {
            const float* tb = C.rope + (size_t)qpos * 32 + 8 * hi;
            const f32x4 c0 = *(const f32x4*)tb, c1 = *(const f32x4*)(tb + 4), s0 = *(const f32x4*)(tb + 16), s1 = *(const f32x4*)(tb + 20);
            const u32x4 a = __builtin_bit_cast(u32x4, qf[4]), bq = __builtin_bit_cast(u32x4, qf[5]); u32x4 oa, ob;
#pragma unroll
            for (int j = 0; j < 4; ++j) {
                const float x1l = bflo(a[j]), x1h = bfhi(a[j]), x2l = bflo(bq[j]), x2h = bfhi(bq[j]);
                const float cl = j < 2 ? c0[2 * j] : c1[2 * j - 4], ch = j < 2 ? c0[2 * j + 1] : c1[2 * j - 3], sl = j < 2 ? s0[2 * j] : s1[2 * j - 4], sh = j < 2 ? s0[2 * j + 1] : s1[2 * j - 3];
                oa[j] = pk2(x1l * cl - x2l * sl, x1h * ch - x2h * sh); ob[j] = pk2(x1l * sl + x2l * cl, x1h * sh + x2h * ch);
            }
            qf[4] = __builtin_bit_cast(bf16x8, oa); qf[5] = __builtin_bit_cast(bf16x8, ob);
        }
        const bf16_t* kv = samp ? C.kvs : C.kvp; const bf16_t* kr = samp ? C.krbs : C.krbp;
        f32x16 O[2]; float l;
        if (samp) sample_pass<96, 64, true, false>(lds, qf, kv + krow0 * 1024 + h * 64, 1024, kr + krow0 * 32, kv + krow0 * 1024 + 512 + h * 64, 1024, 0.10206207261596577f * L2E, 0.f, qpos, O, l, w);
        else flash_pass<96, 64, true, false, false>(lds, qf, kv + krow0 * 1024 + h * 64, 1024, kr + krow0 * 32, kv + krow0 * 1024 + 512 + h * 64, 1024,
                                        nt_unit, nt_wave, nvalid_last, 0.10206207261596577f * L2E, 0.f, qpos, 0, O, l, w);
        l += shfl32(l);
        const float il = 1.f / l;
        if (wvalid) {
            const int ln = lane_id();
            bf16_t* op = C.mix + (size_t)(qrow0 + (ln & 31)) * 1024 + h * 64 + 4 * (ln >> 5);
#pragma unroll
            for (int bk = 0; bk < 2; ++bk)
#pragma unroll
                for (int g = 0; g < 4; ++g) { u32x2 o; o.x = pk2(O[bk][4 * g] * il, O[bk][4 * g + 1] * il); o.y = pk2(O[bk][4 * g + 2] * il, O[bk][4 * g + 3] * il);
                    *(u32x2*)(op + 32 * bk + 8 * g) = o; }
        }
    } else {
        if (samp) diff_unit<true>(lds, C, h, w, nt_unit, nt_wave, nvalid_last, wvalid, qi0, qrow0, krow0);
        else diff_unit<false>(lds, C, h, w, nt_unit, nt_wave, nvalid_last, wvalid, qi0, qrow0, krow0);
    }
}

#define XB_TMO      128
#define XB_XCNT(j)  (256  + 64 * (j))
#define XB_XSUB(j)  (1280 + 64 * (j))
#define XB_XGEN(j)  (2304 + 64 * (j))
#define XB_TOP      3328
#define XB_TOPGEN   3392
#define XCD_BAR_WORDS 3456
#define XB_SPIN_CAP (1u << 18)
__device__ __forceinline__ unsigned xb_ld(unsigned* p)              { return __hip_atomic_load(p, __ATOMIC_RELAXED, __HIP_MEMORY_SCOPE_AGENT); }
__device__ __forceinline__ unsigned xb_add(unsigned* p, unsigned v) { return __hip_atomic_fetch_add(p, v, __ATOMIC_RELAXED, __HIP_MEMORY_SCOPE_AGENT); }
__device__ __forceinline__ unsigned xb_xcc_id() { return (unsigned)__builtin_amdgcn_s_getreg((3 << 11) | 20) & 0xFu; }
#define XB_SPIN(cond, bar) do { unsigned _sp = 0; while (cond) { __builtin_amdgcn_s_sleep(1); \
    if ((++_sp & 255u) == 0u) { if (xb_ld(&(bar)[XB_TMO])) break; if (_sp > XB_SPIN_CAP) { atomicAdd(&(bar)[XB_TMO], 1u); break; } } } } while (0)
__device__ __forceinline__ void xcd_barrier_complete(unsigned* bar, unsigned x, unsigned G, unsigned& nloc, unsigned& nx) {
    unsigned sum, cnt, mine, sp = 0u;
    for (;;) {
        sum = 0u; cnt = 0u; mine = 0u;
#pragma unroll
        for (unsigned j = 0; j < 16; ++j) { const unsigned c = xb_ld(&bar[XB_XCNT(j)]); sum += c; cnt += (c > 0u) ? 1u : 0u; mine = (j == x) ? c : mine; }
        if (sum == G) break;
        __builtin_amdgcn_s_sleep(1);
        if ((++sp & 255u) == 0u) { if (xb_ld(&bar[XB_TMO])) break; if (sp > XB_SPIN_CAP) { atomicAdd(&bar[XB_TMO], 1u); break; } }
    }
    nloc = mine > 0u ? mine : 1u; nx = cnt > 0u ? cnt : 1u;
}
__device__ __forceinline__ void xcd_barrier(unsigned* bar, volatile LAS unsigned* st, unsigned G, int wave) {
    asm volatile("s_waitcnt vmcnt(0) lgkmcnt(0)" ::: "memory");
    __syncthreads();
    if (wave == 0 && lane_id() == 0) {
        const unsigned x = xb_xcc_id();
        __builtin_amdgcn_s_waitcnt(0);
        unsigned nloc = st[0], nx = st[1];
        if (nloc == 0u) { xcd_barrier_complete(bar, x, G, nloc, nx); st[0] = nloc; st[1] = nx; }
        const unsigned old = xb_add(&bar[XB_XSUB(x)], 1u);
        const unsigned gen = old / nloc;
        if (old + 1u == (gen + 1u) * nloc) {
            __builtin_amdgcn_fence(__ATOMIC_RELEASE, "agent");
            asm volatile("s_waitcnt vmcnt(0)" ::: "memory");
            const unsigned og = xb_add(&bar[XB_TOP], 1u);
            const unsigned tg = og / nx;
            if (og + 1u == (tg + 1u) * nx) xb_add(&bar[XB_TOPGEN], 1u);
            else XB_SPIN(xb_ld(&bar[XB_TOPGEN]) == tg, bar);
            __builtin_amdgcn_fence(__ATOMIC_ACQUIRE, "agent");
            xb_add(&bar[XB_XGEN(x)], 1u);
            asm volatile("s_waitcnt vmcnt(0)" ::: "memory");
        } else {
            XB_SPIN(xb_ld(&bar[XB_XGEN(x)]) == gen, bar);
            __builtin_amdgcn_fence(__ATOMIC_ACQUIRE, "agent");
            asm volatile("s_waitcnt vmcnt(0)" ::: "memory");
        }
    }
    __syncthreads();
}
struct Args { const float* in[32]; float* out; unsigned char* ws; int ph_lo, ph_hi; };
constexpr size_t O_YP = 0, O_YS = O_YP + (size_t)TP * DM, O_CKVP = O_YS + (size_t)TS * DM, O_KRP = O_CKVP + (size_t)TP * 256, O_DKP = O_KRP + (size_t)TP * 32, O_DVP = O_DKP + (size_t)TP * 512,
                 O_CONVP = O_DVP + (size_t)TP * 512, O_CKVS = O_CONVP + (size_t)32 * 2 * DFF2, O_KRS = O_CKVS + (size_t)TS * 256, O_DKS = O_KRS + (size_t)TS * 32, O_DVS = O_DKS + (size_t)TS * 512,
                 O_CONVS = O_DVS + (size_t)TS * 512, O_END = O_CONVS + (size_t)32 * 2 * DFF2;

__device__ __forceinline__ void transpose_item(const float* W, int N, int k0, int nsrc0, bf16_t* WT, int K, int ndst0, LAS float* scr, int lane) {
    const int c = lane & 7;
    if (nsrc0 < 0) {
#pragma unroll
        for (int j = 0; j < 4; ++j) { const int n = (lane >> 3) + 8 * j; *(u32x4*)(WT + (size_t)(ndst0 + n) * K + k0 + 8 * c) = (u32x4){0u, 0u, 0u, 0u}; }
        return;
    }
#pragma unroll 8
    for (int i = 0; i < 32; ++i) { const int kk = 2 * i + (lane >> 5); scr[kk * 33 + (lane & 31)] = W[(size_t)(k0 + kk) * N + nsrc0 + (lane & 31)]; }
    LDS_WAIT();
#pragma unroll
    for (int j = 0; j < 4; ++j) { const int n = (lane >> 3) + 8 * j; const LAS float* s = scr + (8 * c) * 33 + n;
        u32x4 o; o.x = pk2(s[0 * 33], s[1 * 33]); o.y = pk2(s[2 * 33], s[3 * 33]); o.z = pk2(s[4 * 33], s[5 * 33]); o.w = pk2(s[6 * 33], s[7 * 33]);
        *(u32x4*)(WT + (size_t)(ndst0 + n) * K + k0 + 8 * c) = o; }
    LDS_WAIT();
}
__device__ __forceinline__ void sincos_d(double a, float& c, float& s) {
    const double TWO_PI = 6.283185307179586476925286766559;
    const double k = __builtin_rint(a / TWO_PI); const double r = a - k * TWO_PI; const double r2 = r * r;
    double sn = 1.0, cs = 1.0;
#pragma unroll
    for (int i = 14; i >= 1; --i) { sn = 1.0 - sn * r2 / (double)((2 * i) * (2 * i + 1)); cs = 1.0 - cs * r2 / (double)((2 * i - 1) * (2 * i)); }
    c = (float)cs; s = (float)(sn * r);
}
__device__ __forceinline__ void ln_row2(const float* hrow, bf16_t* brow, const float* g, const float* bta, float* stat, int lane) {
    f32x4 v[2][4]; float s[2] = {0.f, 0.f};
#pragma unroll
    for (int r = 0; r < 2; ++r)
#pragma unroll
        for (int j = 0; j < 4; ++j) v[r][j] = *((const f32x4*)(hrow + (size_t)r * DM) + lane + 64 * j);
#pragma unroll
    for (int r = 0; r < 2; ++r)
#pragma unroll
        for (int j = 0; j < 4; ++j) s[r] += (v[r][j].x + v[r][j].y) + (v[r][j].z + v[r][j].w);
    float mean[2], rstd[2];
#pragma unroll
    for (int r = 0; r < 2; ++r) { mean[r] = wave_sum(s[r]) * (1.f / 1024.f); float s2 = 0.f;
#pragma unroll
        for (int j = 0; j < 4; ++j) { v[r][j] = v[r][j] - mean[r]; s2 += (v[r][j].x * v[r][j].x + v[r][j].y * v[r][j].y) + (v[r][j].z * v[r][j].z + v[r][j].w * v[r][j].w); }
        rstd[r] = 1.f / sqrtf(wave_sum(s2) * (1.f / 1024.f) + EPS); }
    if (lane == 0) { *(f32x2*)stat = (f32x2){mean[0], rstd[0]}; *(f32x2*)(stat + 2) = (f32x2){mean[1], rstd[1]}; }
#pragma unroll
    for (int j = 0; j < 4; ++j) { const f32x4 gg = *((const f32x4*)g + lane + 64 * j), bb = *((const f32x4*)bta + lane + 64 * j);
#pragma unroll
        for (int r = 0; r < 2; ++r) { const f32x4 y = v[r][j] * rstd[r] * gg + bb; u32x2 o; o.x = pk2(y.x, y.y); o.y = pk2(y.z, y.w); *((u32x2*)(brow + (size_t)r * DM) + lane + 64 * j) = o; } }
}

__global__ void __launch_bounds__(NTHR, 2) fwd_kernel(Args args) {
    extern __shared__ __attribute__((aligned(16))) unsigned char lds_raw[];
    LAS unsigned char* lds = (LAS unsigned char*)lds_raw;
    cg::grid_group grid = cg::this_grid();
    const int wave = __builtin_amdgcn_readfirstlane((int)threadIdx.x >> 6);
    const int G = gridDim.x, bx = blockIdx.x;
    const int gw = bx * NWAVES + wave, NGW = G * NWAVES;
    const size_t NGT = (size_t)G * NTHR;
#define PHASE_IDS() const int lane = lane_id(); const int tid = wave * 64 + lane; const size_t gt = (size_t)bx * NTHR + tid; (void)tid; (void)gt
    unsigned char* ws = args.ws;
    float* out = args.out;
    const float* const* in = args.in;
    unsigned* ctl = (unsigned*)(ws + WS_CTL);
    float* rope = (float*)(ws + WS_ROPE);
    float* ctab = (float*)(ws + WS_CTAB);
    float* uspec = (float*)(ws + WS_USPEC);
    float* stat1 = (float*)(ws + WS_PARK); float* stat2 = stat1 + 2 * (size_t)T;
    bf16_t *win_t = (bf16_t*)(ws + WS_WIN), *wuq_t = (bf16_t*)(ws + WS_WUQ), *wukv_t = (bf16_t*)(ws + WS_WUKV), *wo_t = (bf16_t*)(ws + WS_WO), *wup_t = (bf16_t*)(ws + WS_WUP),
           *wdn_t = (bf16_t*)(ws + WS_WDN), *wg_t = (bf16_t*)(ws + WS_WG), *wpp_t = (bf16_t*)(ws + WS_WPP);
    bf16_t *pb = (bf16_t*)(ws + WS_PB), *proj = (bf16_t*)(ws + WS_PROJ), *xb = (bf16_t*)(ws + WS_XB), *cqb = (bf16_t*)(ws + WS_CQB), *callp = (bf16_t*)(ws + WS_CALLP), *calls = (bf16_t*)(ws + WS_CALLS);
    bf16_t *mix = (bf16_t*)(ws + WS_MIX), *pp = (bf16_t*)(ws + WS_PP), *dks = (bf16_t*)(ws + WS_DKS), *dvs = (bf16_t*)(ws + WS_DVS), *qa = (bf16_t*)(ws + WS_QA), *kvp = (bf16_t*)(ws + WS_KVP), *kvs = (bf16_t*)(ws + WS_KVS);
    bf16_t *krbp = (bf16_t*)(ws + WS_KRBP), *krbs = (bf16_t*)(ws + WS_KRBS), *h1b = (bf16_t*)(ws + WS_H1B) + 2 * DM, *act = (bf16_t*)(ws + WS_ACT), *h2b = (bf16_t*)(ws + WS_H2B);
    float* hbuf = (float*)(ws + WS_H);
    const int lo = args.ph_lo, hi_ph = args.ph_hi;
#define IN(k) (lo <= (k) && (k) < hi_ph)
#define SEAM(k) do { if (IN(k) && IN((k) + 1)) xcd_barrier(xbar, xst, (unsigned)G, wave); } while (0)
    unsigned* xbar = ctl + 256;
    volatile LAS unsigned* xst = (volatile LAS unsigned*)(lds + LDS_BYTES - 16);
    if (wave == 0 && lane_id() == 0) { xst[0] = 0u; xst[1] = 0u; (void)xb_add(&xbar[XB_XCNT(xb_xcc_id())], 1u); }
    __syncthreads();
    if (lo < -1000) grid.sync();

    if (IN(0)) {
        PHASE_IDS();
        if (bx == 0 && tid == 0) {
            float s1 = 0.f, s2 = 0.f;
            for (int i = 0; i < 64; ++i) { s1 += in[15][i] * in[16][i]; s2 += in[17][i] * in[18][i]; }
            ((float*)ctl)[1] = __expf(s1) - __expf(s2) + 0.2f;
            ctl[0] = 0u; ctl[2] = 0u; ctl[4] = 0u;
        }
        LAS float* scr = (LAS float*)(lds + wave * 16384);
        constexpr int I_IN = 16 * 72, I_UQ = 4 * 24, I_UKV = 4 * 32, I_O = 16 * 32, I_UP = 16 * 176, I_DN = 44 * 32, I_G = 16 * 32, I_PP = 4 * 32;
        constexpr int NITEMS = I_IN + I_UQ + I_UKV + I_O + I_UP + I_DN + I_G + I_PP;
        for (int it = gw; it < NITEMS; it += NGW) {
            int r = it;
            if (r < I_IN) { const int kb = r / 72, nb = r % 72, nd = nb * 32; int ns;
                if (nd < 512) ns = nd; else if (nd < 2048) ns = nd + 32; else if (nd < 2080) ns = nd - 2048 + 512; else ns = -1;
                transpose_item(in[9], 2080, kb * 64, ns, win_t, 1024, nd, scr, lane); continue; } r -= I_IN;
            if (r < I_UQ) { transpose_item(in[11], 768, (r / 24) * 64, (r % 24) * 32, wuq_t, 256, (r % 24) * 32, scr, lane); continue; } r -= I_UQ;
            if (r < I_UKV) { const int kb = r / 32, nb = r % 32; if (nb < 16) transpose_item(in[13], 512, kb * 64, nb * 32, wukv_t, 256, nb * 32, scr, lane);
                else transpose_item(in[14], 512, kb * 64, (nb - 16) * 32, wukv_t, 256, nb * 32, scr, lane); continue; } r -= I_UKV;
            if (r < I_O) { transpose_item(in[20], 1024, (r / 32) * 64, (r % 32) * 32, wo_t, 1024, (r % 32) * 32, scr, lane); continue; } r -= I_O;
            if (r < I_UP) { const int kb = r / 176, nb = r % 176, nd = nb * 32;
                const int pn = nd >> 8, bj = (nd >> 7) & 1, c = nd & 127; transpose_item(in[23], DFF2, kb * 64, bj * DFF + 128 * pn + c, wup_t, 1024, nd, scr, lane); continue; } r -= I_UP;
            if (r < I_DN) { transpose_item(in[26], 1024, (r / 32) * 64, (r % 32) * 32, wdn_t, DFF, (r % 32) * 32, scr, lane); continue; } r -= I_DN;
            if (r < I_G) { transpose_item(in[29], 1024, (r / 32) * 64, (r % 32) * 32, wg_t, 1024, (r % 32) * 32, scr, lane); continue; } r -= I_G;
            transpose_item(in[31], 1024, (r / 32) * 64, (r % 32) * 32, wpp_t, 256, (r % 32) * 32, scr, lane);
        }
        {
#define CVT_PASS(N_, SH_, MSK_, W_, SRCP_, SRCS_, DST_) do { size_t i0 = gt; \
            for (; i0 + 3 * NGT < (N_); i0 += 4 * NGT) { f32x4 a_[4], b_[4]; \
                _Pragma("unroll") for (int j = 0; j < 4; ++j) { const size_t i = i0 + (size_t)j * NGT; const size_t row = i >> (SH_); const int c8 = (int)(i & (MSK_)); \
                    const float* src = row < TP ? (SRCP_) + row * (W_) : (SRCS_) + (row - TP) * (W_); a_[j] = *(const f32x4*)(src + c8 * 8); b_[j] = *(const f32x4*)(src + c8 * 8 + 4); } \
                _Pragma("unroll") for (int j = 0; j < 4; ++j) { const size_t i = i0 + (size_t)j * NGT; const size_t row = i >> (SH_); const int c8 = (int)(i & (MSK_)); \
                    u32x4 o; o.x = pk2(a_[j].x, a_[j].y); o.y = pk2(a_[j].z, a_[j].w); o.z = pk2(b_[j].x, b_[j].y); o.w = pk2(b_[j].z, b_[j].w); *(u32x4*)((DST_) + row * (W_) + c8 * 8) = o; } } \
            for (; i0 < (N_); i0 += NGT) { const size_t row = i0 >> (SH_); const int c8 = (int)(i0 & (MSK_)); \
                const float* src = row < TP ? (SRCP_) + row * (W_) : (SRCS_) + (row - TP) * (W_); const f32x4 a_ = *(const f32x4*)(src + c8 * 8), b_ = *(const f32x4*)(src + c8 * 8 + 4); \
                u32x4 o; o.x = pk2(a_.x, a_.y); o.y = pk2(a_.z, a_.w); o.z = pk2(b_.x, b_.y); o.w = pk2(b_.z, b_.w); *(u32x4*)((DST_) + row * (W_) + c8 * 8) = o; } } while (0)
            CVT_PASS((size_t)T * 128, 7, 127, DM, in[0], in[1], xb);
            CVT_PASS((size_t)T * 32, 5, 31, 256, in[7], in[8], pb);
#undef CVT_PASS
        }
        for (size_t i = gt; i < (size_t)DFF; i += NGT) { const float* cw = in[24]; const float* cb = in[25];
            float* t = ctab + (i >> 2) * 32 + (i & 3); t[0] = cw[i]; t[4] = cw[DFF2 + i]; t[8] = cw[2 * DFF2 + i]; t[12] = cb[i];
            t[16] = cw[DFF + i]; t[20] = cw[DFF2 + DFF + i]; t[24] = cw[2 * DFF2 + DFF + i]; t[28] = cb[DFF + i]; }
        for (size_t i = gt; i < (size_t)SK * 16; i += NGT) { const int pos = (int)(i >> 4), k = (int)(i & 15); const float ang = (float)pos * ROPE_INV[k];
            float c, s; sincos_d((double)ang, c, s); rope[pos * 32 + k] = c; rope[pos * 32 + 16 + k] = s; }
    }
    SEAM(0);
    if (IN(1)) {
        pg8::Gemm g{xb, win_t, DM, DM}; pg8::StaticOrder S; S.init(T / 256, NIN / 256, G, bx); pg8::EpiProj E{proj, out + O_DKP, out + O_DKS, out + O_DVP, out + O_DVS};
        pg8::gemm_phase<pg8::EpiProj, 0>(lds, g, S, E, wave);
    }
    SEAM(1);
    if (IN(2)) {
        PHASE_IDS();
        for (int rb = gw * 4; rb < T; rb += NGW * 4) {
            u32x2 wq[4], wc[4]; unsigned short xa[4], xb2[4];
#pragma unroll
            for (int j = 0; j < 4; ++j) { const bf16_t* pr = proj + (size_t)(rb + j) * NIN; wq[j] = *(const u32x2*)(pr + 4 * lane); wc[j] = *(const u32x2*)(pr + 256 + 4 * lane);
                xa[j] = pr[2048 + (lane & 15)]; xb2[j] = pr[2064 + (lane & 15)]; }
            const f32x4 gq = *(const f32x4*)(in[10] + 4 * lane), gk = *(const f32x4*)(in[12] + 4 * lane);
#pragma unroll
            for (int j = 0; j < 4; ++j) {
                const int row = rb + j;
                const bool samp = row >= TP; const int sr = row - TP, sbb = sr >> 5, si = sr & 31;
                const size_t crw = samp ? (size_t)sbb * SK + 2048 + si : (size_t)row;
                const int pos = samp ? 2048 + si : (row & 2047);
                {
                    const u32x2 w = wq[j]; const float a0 = bflo(w.x), a1 = bfhi(w.x), a2 = bflo(w.y), a3 = bfhi(w.y);
                    const float r = 1.f / sqrtf(wave_sum(a0 * a0 + a1 * a1 + a2 * a2 + a3 * a3) * (1.f / 256.f) + EPS);
                    u32x2 o; o.x = pk2(a0 * r * gq.x, a1 * r * gq.y); o.y = pk2(a2 * r * gq.z, a3 * r * gq.w); *(u32x2*)(cqb + (size_t)row * 256 + 4 * lane) = o;
                }
                {
                    const u32x2 w = wc[j]; const float a0 = bflo(w.x), a1 = bfhi(w.x), a2 = bflo(w.y), a3 = bfhi(w.y);
                    const float r = 1.f / sqrtf(wave_sum(a0 * a0 + a1 * a1 + a2 * a2 + a3 * a3) * (1.f / 256.f) + EPS);
                    const f32x4 y = {a0 * r * gk.x, a1 * r * gk.y, a2 * r * gk.z, a3 * r * gk.w};
                    __builtin_nontemporal_store(y, (f32x4*)((samp ? out + O_CKVS + (size_t)sr * 256 : out + O_CKVP + (size_t)row * 256) + 4 * lane));
                    u32x2 o; o.x = pk2(y.x, y.y); o.y = pk2(y.z, y.w); *(u32x2*)((samp ? calls + crw * 256 : callp + (size_t)row * 256) + 4 * lane) = o;
                }
                if (lane < 16) {
                    const float x1 = __uint_as_float((unsigned)xa[j] << 16), x2 = __uint_as_float((unsigned)xb2[j] << 16);
                    const float c = rope[pos * 32 + lane], sn = rope[pos * 32 + 16 + lane]; const float o1 = x1 * c - x2 * sn, o2 = x1 * sn + x2 * c;
                    float* ko = samp ? out + O_KRS + (size_t)sr * 32 : out + O_KRP + (size_t)row * 32; ko[lane] = o1; ko[16 + lane] = o2;
                    bf16_t* kb = samp ? krbs + crw * 32 : krbp + (size_t)row * 32; kb[lane] = (bf16_t)(pk2(o1, 0.f) & 0xffffu); kb[16 + lane] = (bf16_t)(pk2(o2, 0.f) & 0xffffu);
                }
                if (samp) { const bf16_t* pr = proj + (size_t)row * NIN; const u32x4 wk = *(const u32x4*)(pr + 1024 + 8 * lane), wv = *(const u32x4*)(pr + 1536 + 8 * lane);
                    *(u32x4*)(dks + crw * 512 + 8 * lane) = wk; *(u32x4*)(dvs + crw * 512 + 8 * lane) = wv; }
            }
        }
        for (int idx0 = gw; idx0 < 32 * PAST; idx0 += 2 * NGW) {
            f32x4 ac[2], k0[2], k1[2], v0[2], v1[2]; f32x2 ar[2];
#pragma unroll
            for (int j = 0; j < 2; ++j) { const int idx = idx0 + j * NGW; if (idx < 32 * PAST) {
                ac[j] = *(const f32x4*)(in[2] + (size_t)idx * 256 + 4 * lane); ar[j] = *(const f32x2*)(in[3] + (size_t)idx * 32 + 2 * (lane & 15));
                k0[j] = *(const f32x4*)(in[4] + (size_t)idx * 512 + 8 * lane); k1[j] = *(const f32x4*)(in[4] + (size_t)idx * 512 + 8 * lane + 4);
                v0[j] = *(const f32x4*)(in[5] + (size_t)idx * 512 + 8 * lane); v1[j] = *(const f32x4*)(in[5] + (size_t)idx * 512 + 8 * lane + 4); } }
#pragma unroll
            for (int j = 0; j < 2; ++j) { const int idx = idx0 + j * NGW; if (idx < 32 * PAST) {
                const int b = idx >> 11, sq = idx & 2047; const size_t crw = (size_t)b * SK + sq;
                { u32x2 o; o.x = pk2(ac[j].x, ac[j].y); o.y = pk2(ac[j].z, ac[j].w); *(u32x2*)(calls + crw * 256 + 4 * lane) = o; }
                if (lane < 16) *(unsigned*)(krbs + crw * 32 + 2 * lane) = pk2(ar[j].x, ar[j].y);
                { u32x4 o; o.x = pk2(k0[j].x, k0[j].y); o.y = pk2(k0[j].z, k0[j].w); o.z = pk2(k1[j].x, k1[j].y); o.w = pk2(k1[j].z, k1[j].w); *(u32x4*)(dks + crw * 512 + 8 * lane) = o; }
                { u32x4 o; o.x = pk2(v0[j].x, v0[j].y); o.y = pk2(v0[j].z, v0[j].w); o.z = pk2(v1[j].x, v1[j].y); o.w = pk2(v1[j].z, v1[j].w); *(u32x4*)(dvs + crw * 512 + 8 * lane) = o; } } }
        }
        for (int r = gw; r < 32; r += NGW) {
            const size_t crw = (size_t)32 * SK + r; const u32x4 z = {0u, 0u, 0u, 0u};
            *(u32x4*)(dks + crw * 512 + 8 * lane) = z; *(u32x4*)(dvs + crw * 512 + 8 * lane) = z; *(u32x4*)(kvs + crw * 1024 + 8 * lane) = z; *(u32x4*)(kvs + crw * 1024 + 512 + 8 * lane) = z;
            if (lane < 4) *(u32x4*)(krbs + crw * 32 + 8 * lane) = z;
        }
    }
    SEAM(2);
    if (IN(3)) {
        { pg8::Gemm g{cqb, wuq_t, 256, 256}; pg8::StaticOrder S; S.init(T / 256, 3, G, bx); pg8::EpiBf16 E{qa, 768}; pg8::gemm_phase<pg8::EpiBf16, 0>(lds, g, S, E, wave); }
        { pg8::Gemm g{callp, wukv_t, 256, 256}; pg8::StaticOrder S; S.init(TP / 256, 4, G, bx); pg8::EpiBf16 E{kvp, 1024}; pg8::gemm_phase<pg8::EpiBf16, 0>(lds, g, S, E, wave); }
        { pg8::Gemm g{calls, wukv_t, 256, 256}; pg8::StaticOrder S; S.init(32 * SK / 256, 4, G, bx); pg8::EpiBf16 E{kvs, 1024}; pg8::gemm_phase<pg8::EpiBf16, 0>(lds, g, S, E, wave); }
    }
    SEAM(3);
    if (IN(4)) {
        AttnCtx C{qa, proj, kvp, kvs, krbp, krbs, dks, dvs, mix, rope, in[19], __int_as_float(__builtin_amdgcn_readfirstlane(__float_as_int(((const float*)ctl)[1]))), (float*)(ws + WS_PARK)};
        LAS int* su = (LAS int*)lds;
        for (int rep = 0; rep < P4_REPEAT; ++rep)
        for (;;) {
            if (wave == 0) { const int ln = lane_id(); if (ln == 0) su[0] = (int)atomicAdd(ctl + 2 * rep + ln, 1u); }
            __syncthreads();
            const int idx = su[0];
            __syncthreads();
            if (idx >= ATT_UNITS) break;
            int wv = wave; asm volatile("" : "+s"(wv));
            attn_unit(lds + 256, C, idx, wv);
        }
    }
    SEAM(4);
    if (IN(5)) {
        pg8::Gemm g{mix, wo_t, DM, DM}; pg8::StaticOrder S; S.init(T / 256, 4, G, bx); pg8::EpiResX E{in[0], in[1], hbuf};
        pg8::gemm_phase<pg8::EpiResX, 0>(lds, g, S, E, wave);
    }
    SEAM(5);
    if (IN(6)) { PHASE_IDS(); for (int row = 2 * gw; row < T; row += 2 * NGW) ln_row2(hbuf + (size_t)row * DM, h1b + (size_t)row * DM, in[21], in[22], stat1 + 2 * (size_t)row, lane); }
    SEAM(6);
    if (IN(7)) {
        pg8::Gemm g{h1b - 2 * DM, wup_t, DM, DM}; pg8::StaticOrder S; S.init(265, 22, G, bx);
        pg8::EpiConvGlu E{act, ctab, uspec};
        for (int rep = 0; rep < P7_REPEAT; ++rep) pg8::gemm_phase<pg8::EpiConvGlu, 1>(lds, g, S, E, wave);
    }
    SEAM(7);
    if (IN(8)) {
        PHASE_IDS();
        for (size_t i = gt; i < (size_t)65 * (DFF / 2); i += NGT) {
            const int si = (int)(i / (DFF / 2)), j = 2 * (int)(i % (DFF / 2));
            const float* us = uspec + (size_t)si * 4 * DFF2;
            const int s = si <= 32 ? si * 2048 : TP + (si - 32) * 32;
            if (si >= 1) { float* o = (si <= 32 ? out + O_CONVP + (size_t)(si - 1) * 2 * DFF2 : out + O_CONVS + (size_t)(si - 33) * 2 * DFF2);
                *(f32x2*)(o + j) = *(const f32x2*)(us + j); *(f32x2*)(o + DFF + j) = *(const f32x2*)(us + DFF + j);
                *(f32x2*)(o + DFF2 + j) = *(const f32x2*)(us + DFF2 + j); *(f32x2*)(o + DFF2 + DFF + j) = *(const f32x2*)(us + DFF2 + DFF + j); }
            if (si < 64) {
                f32x2 sg0 = {0.f, 0.f}, sg1 = {0.f, 0.f}, sv0 = {0.f, 0.f}, sv1 = {0.f, 0.f};
                if (si >= 32) { const float* st = in[6] + (size_t)(si - 32) * 2 * DFF2; sg0 = *(const f32x2*)(st + j); sv0 = *(const f32x2*)(st + DFF + j); sg1 = *(const f32x2*)(st + DFF2 + j); sv1 = *(const f32x2*)(st + DFF2 + DFF + j); }
                const f32x2 ug0 = *(const f32x2*)(us + 2 * DFF2 + j), uv0 = *(const f32x2*)(us + 2 * DFF2 + DFF + j), ug1 = *(const f32x2*)(us + 3 * DFF2 + j), uv1 = *(const f32x2*)(us + 3 * DFF2 + DFF + j);
                f32x2 zg0, zv0, zg1, zv1;
#pragma unroll
                for (int e = 0; e < 2; ++e) { const float* tb = ctab + (size_t)((j + e) >> 2) * 32 + ((j + e) & 3);
                    zg0[e] = tb[12] + tb[0] * sg0[e] + tb[4] * sg1[e] + tb[8] * ug0[e]; zv0[e] = tb[28] + tb[16] * sv0[e] + tb[20] * sv1[e] + tb[24] * uv0[e];
                    zg1[e] = tb[12] + tb[0] * sg1[e] + tb[4] * ug0[e] + tb[8] * ug1[e]; zv1[e] = tb[28] + tb[16] * sv1[e] + tb[20] * uv0[e] + tb[24] * uv1[e]; }
                const f32x2 r0 = gelu_pk(zg0) * zv0, r1 = gelu_pk(zg1) * zv1;
                *(unsigned*)(act + (size_t)s * DFF + j) = pk2(r0.x, r0.y); *(unsigned*)(act + (size_t)(s + 1) * DFF + j) = pk2(r1.x, r1.y);
            }
        }
    }
    SEAM(8);
    if (IN(9)) {
        { pg8::Gemm g{act, wdn_t, DFF, DFF}; pg8::StaticOrder S; S.init(T / 256, 4, G, bx); pg8::EpiResH E{hbuf, stat1, in[21], in[22]}; pg8::gemm_phase<pg8::EpiResH, 0>(lds, g, S, E, wave); }
        if (bx >= 16) { pg8::Gemm g{pb, wpp_t, 256, 256}; pg8::StaticOrder S; S.init(T / 256, 4, G - 16, bx - 16); pg8::EpiBf16 E{pp, DM}; pg8::gemm_phase<pg8::EpiBf16, 0>(lds, g, S, E, wave); }
    }
    SEAM(9);
    if (IN(10)) { PHASE_IDS(); for (int row = 2 * gw; row < T; row += 2 * NGW) ln_row2(hbuf + (size_t)row * DM, h2b + (size_t)row * DM, in[27], in[28], stat2 + 2 * (size_t)row, lane); }
    SEAM(10);
    if (IN(11)) {
        pg8::Gemm g{h2b, wg_t, DM, DM}; pg8::StaticOrder S; S.init(T / 256, 4, G, bx); pg8::EpiGate E{hbuf, pp, in[30], out + O_YP, out + O_YS, stat2, in[27], in[28]};
        pg8::gemm_phase<pg8::EpiGate, 0>(lds, g, S, E, wave);
    }
#undef IN
#undef SEAM
}

extern "C" void kernel_launch(void* const* d_in, const int* in_sizes, int n_in, void* d_out, int out_size, void* d_ws, size_t ws_size, hipStream_t stream) {
    static int grid = 0;
    if (grid == 0) {
        if ((size_t)out_size != O_END) fprintf(stderr, "kernel_launch: note: out_size %d, expected %zu\n", out_size, (size_t)O_END);
        if (n_in != 32 || ws_size < WS_END) { fprintf(stderr, "kernel_launch: unexpected sizes: n_in %d out %d (want %zu) ws %zu (want %zu)\n", n_in, out_size, (size_t)O_END, ws_size, (size_t)WS_END); grid = -1; return; }
        int dev = 0, cus = 0, per_cu = 0;
        hipGetDevice(&dev); hipDeviceGetAttribute(&cus, hipDeviceAttributeMultiprocessorCount, dev);
        if (hipFuncSetAttribute((const void*)fwd_kernel, hipFuncAttributeMaxDynamicSharedMemorySize, LDS_BYTES) != hipSuccess) { fprintf(stderr, "kernel_launch: hipFuncSetAttribute failed\n"); grid = -1; return; }
        if (hipOccupancyMaxActiveBlocksPerMultiprocessor(&per_cu, (const void*)fwd_kernel, NTHR, LDS_BYTES) != hipSuccess || per_cu < 1) { fprintf(stderr, "kernel_launch: occupancy query says %d blocks/CU\n", per_cu); per_cu = 1; }
        (void)hipGetLastError();
        grid = cus;
    }
    if (grid < 0) return;
    Args a{};
    for (int i = 0; i < 32; ++i) a.in[i] = (const float*)d_in[i];
    a.out = (float*)d_out; a.ws = (unsigned char*)d_ws;
    (void)hipMemsetAsync((char*)d_ws + WS_CTL, 0, 16384, stream);
#if N_LAUNCH_MODE == 1
    a.ph_lo = 0; a.ph_hi = 12;
    { void* kargs[] = {&a}; hipError_t e = hipLaunchCooperativeKernel((const void*)fwd_kernel, dim3(grid), dim3(NTHR), kargs, LDS_BYTES, stream);
      if (e != hipSuccess) fprintf(stderr, "kernel_launch: cooperative launch failed: %s (grid %d)\n", hipGetErrorString(e), grid); }
#else
    for (int p = 0; p < 12; ++p) { a.ph_lo = p; a.ph_hi = p + 1; void* kargs[] = {&a};
        hipError_t e = hipLaunchCooperativeKernel((const void*)fwd_kernel, dim3(grid), dim3(NTHR), kargs, LDS_BYTES, stream);
        if (e != hipSuccess) { fprintf(stderr, "kernel_launch: launch %d failed: %s\n", p, hipGetErrorString(e)); break; } }
#endif
}
```
